# Optimizing an MI355X kernel written in HIP

```python
import jax, jax.numpy as jnp
from jax import lax
import numpy as np

D_MODEL = 1024
BATCH = 2
SEQ = 8192
DEPTH = 2
DEC_BATCH = 32
DEC_SEQ = 64
PAST_LEN = 4096

CHUNK = 64
PLE_DIM = 256
D_FF = 4 * D_MODEL
RET_HEADS = 4
RET_DK = 128
RET_DV = 128
DN_HEADS = 4
DN_DK = 128
DN_DV = 128
CONV_W = 4
ROPE_BASE = 10000.0
EPS = 1e-6
RET_W = RET_HEADS * RET_DV
DN_W = DN_HEADS * DN_DV
MIX_W = RET_W + DN_W
DN_CONV_CH = DN_HEADS * (2 * DN_DK + DN_DV)
IN_COLS = 2 * RET_HEADS * RET_DK + RET_W + RET_W + DN_CONV_CH + DN_W + 2 * DN_HEADS

kernel_name = 'hybrid_retention_gated_deltanet_stream_step'


def _rmsnorm(x, g):
    xf = x.astype(jnp.float32)
    y = xf * lax.rsqrt(jnp.mean(xf * xf, axis=-1, keepdims=True) + EPS)
    return (y * g.astype(jnp.float32)).astype(x.dtype)


def _head_layernorm(o, g):
    mu = jnp.mean(o, axis=-1, keepdims=True)
    oc = o - mu
    var = jnp.mean(oc * oc, axis=-1, keepdims=True)
    return oc * lax.rsqrt(var + EPS) * g.astype(jnp.float32).reshape(o.shape[-2:])


def _l2norm(x):
    return x * lax.rsqrt(jnp.sum(x * x, axis=-1, keepdims=True) + EPS)


def _rope(x, pos):
    half = x.shape[-1] // 2
    inv = ROPE_BASE ** (-jnp.arange(half, dtype=jnp.float32) / half)
    ang = pos.astype(jnp.float32)[:, None] * inv[None, :]
    cos = jnp.cos(ang)[None, :, None, :]
    sin = jnp.sin(ang)[None, :, None, :]
    x1, x2 = x[..., :half], x[..., half:]
    return jnp.concatenate([x1 * cos - x2 * sin, x1 * sin + x2 * cos], axis=-1)


def _causal_conv(x, buf, w):
    T = x.shape[1]
    xp = jnp.concatenate([buf.astype(x.dtype), x], axis=1)
    y = xp[:, 0:T] * w[0]
    for i in range(1, CONV_W):
        y = y + xp[:, i:i + T] * w[i]
    return y, xp[:, -(CONV_W - 1):]


def _retention(q, k, v, s0):
    B, T, H, DK = q.shape
    DV = v.shape[-1]
    C = min(CHUNK, T)
    N = T // C
    log_gamma = jnp.log(1.0 - 2.0 ** (-5.0 - jnp.arange(H, dtype=jnp.float32)))
    idx = jnp.arange(C, dtype=jnp.float32)
    intra = jnp.exp(jnp.abs(idx[:, None] - idx[None, :])[None] * log_gamma[:, None, None])
    cross = jnp.exp((idx + 1.0)[None, :] * log_gamma[:, None])
    inject = jnp.exp((C - 1.0 - idx)[None, :] * log_gamma[:, None])
    carry = jnp.exp(C * log_gamma)
    qc = q.reshape(B, N, C, H, DK)
    kc = k.reshape(B, N, C, H, DK)
    vc = v.reshape(B, N, C, H, DV)
    scores = jnp.einsum('bnihd,bnjhd->bnhij', qc, kc) * intra
    o = jnp.einsum('bnhij,bnjhv->bnihv', scores, vc)
    u = jnp.einsum('bnjhd,bnjhv,hj->nbhdv', kc, vc, inject)

    def step(s, u_n):
        return s * carry[:, None, None] + u_n, s

    s_final, s_prev = lax.scan(step, s0, u)
    o = o + jnp.einsum('bnihd,nbhdv,hi->bnihv', qc, s_prev, cross)
    return o.reshape(B, T, H, DV), s_final


def _gated_delta(q, k, v, g, beta, s0):
    B, T, H, DK = q.shape
    DV = v.shape[-1]
    C = min(CHUNK, T)
    N = T // C

    def chunks(x):
        x = x.reshape((B, N, C, H) + x.shape[3:])
        return jnp.moveaxis(x, 3, 2)

    qc, kc, vc = chunks(q), chunks(k), chunks(v)
    gc = jnp.cumsum(chunks(g), axis=-1)
    bc = chunks(beta)
    idx = jnp.arange(C)
    causal = idx[:, None] >= idx[None, :]
    strict = idx[:, None] > idx[None, :]
    decay = jnp.exp(jnp.where(causal, gc[..., :, None] - gc[..., None, :], -jnp.inf))
    kb = kc * bc[..., None]
    a = jnp.where(strict, jnp.einsum('bnhid,bnhjd->bnhij', kb, kc) * decay, 0.0)
    lhs = a + jnp.eye(C, dtype=a.dtype)
    rhs = jnp.concatenate([vc * bc[..., None], kb * jnp.exp(gc)[..., None]], axis=-1)
    sol = lax.linalg.triangular_solve(lhs, rhs, left_side=True, lower=True, unit_diagonal=True)
    u, w = sol[..., :DV], sol[..., DV:]
    attn = jnp.einsum('bnhid,bnhjd->bnhij', qc, kc) * decay
    qg = qc * jnp.exp(gc)[..., None]
    kg = kc * jnp.exp(gc[..., -1:] - gc)[..., None]
    g_end = jnp.exp(gc[..., -1])
    xs = tuple(jnp.moveaxis(t, 1, 0) for t in (u, w, attn, qg, kg, g_end))

    def step(s, inp):
        u_n, w_n, attn_n, qg_n, kg_n, ge_n = inp
        v_new = u_n - jnp.einsum('bhcd,bhdv->bhcv', w_n, s)
        o_n = jnp.einsum('bhcd,bhdv->bhcv', qg_n, s) + jnp.einsum('bhij,bhjv->bhiv', attn_n, v_new)
        s = s * ge_n[..., None, None] + jnp.einsum('bhcd,bhcv->bhdv', kg_n, v_new)
        return s, o_n

    s_final, o = lax.scan(step, s0, xs)
    o = jnp.transpose(o, (1, 0, 3, 2, 4)).reshape(B, T, H, DV)
    return o, s_final


def _layer(h, p, conv_buf, s_ret, s_dn, pos0, norm1_g, w_in, conv_w, dt_bias, a_log, ret_norm_g,
           dn_norm_g, w_out, norm2_g, w_up, w_down, ple_proj, ple_norm_g, ple_gate_w, ple_gate_b):
    B, T, _ = h.shape
    f32 = jnp.float32
    xn = _rmsnorm(h, norm1_g)
    z = xn @ w_in
    sizes = [RET_HEADS * RET_DK, RET_HEADS * RET_DK, RET_W, RET_W, DN_CONV_CH, DN_W, DN_HEADS, DN_HEADS]
    offs = [int(o) for o in np.cumsum(sizes)[:-1]]
    q_a, k_a, v_a, g_a, qkv_b, g_b, b_b, a_b = jnp.split(z, offs, axis=-1)

    pos = pos0 + jnp.arange(T)
    q_a = _rope(q_a.reshape(B, T, RET_HEADS, RET_DK).astype(f32), pos)
    k_a = _rope(k_a.reshape(B, T, RET_HEADS, RET_DK).astype(f32), pos) * (RET_DK ** -0.5)
    v_a = v_a.reshape(B, T, RET_HEADS, RET_DV).astype(f32)
    o_a, s_ret_new = _retention(q_a, k_a, v_a, s_ret.astype(f32))
    o_a = _head_layernorm(o_a, ret_norm_g) * jax.nn.silu(g_a.astype(f32)).reshape(B, T, RET_HEADS, RET_DV)

    c, conv_new = _causal_conv(qkv_b, conv_buf, conv_w)
    c = jax.nn.silu(c.astype(f32))
    q_b, k_b, v_b = jnp.split(c, [DN_HEADS * DN_DK, 2 * DN_HEADS * DN_DK], axis=-1)
    q_b = _l2norm(q_b.reshape(B, T, DN_HEADS, DN_DK)) * (DN_DK ** -0.5)
    k_b = _l2norm(k_b.reshape(B, T, DN_HEADS, DN_DK))
    v_b = v_b.reshape(B, T, DN_HEADS, DN_DV)
    g = -jnp.exp(a_log.astype(f32)) * jax.nn.softplus(a_b.astype(f32) + dt_bias.astype(f32))
    beta = jax.nn.sigmoid(b_b.astype(f32))
    o_b, s_dn_new = _gated_delta(q_b, k_b, v_b, g, beta, s_dn.astype(f32))
    o_b = _rmsnorm(o_b, dn_norm_g) * jax.nn.silu(g_b.astype(f32)).reshape(B, T, DN_HEADS, DN_DV)

    mix = jnp.concatenate([o_a.reshape(B, T, RET_W), o_b.reshape(B, T, DN_W)], axis=-1).astype(h.dtype)
    h = h + mix @ w_out
    up = jax.nn.relu(_rmsnorm(h, norm2_g) @ w_up)
    h = h + (up * up) @ w_down
    gate = jax.nn.sigmoid(_rmsnorm(h, ple_norm_g) @ ple_gate_w + ple_gate_b)
    h = h + (p @ ple_proj) * gate
    return h, s_ret_new.astype(s_ret.dtype), s_dn_new.astype(s_dn.dtype), conv_new


def _trunk(x, p, conv_bufs, s_rets, s_dns, pos0, layer_weights, final_norm_g):
    h = x
    new_ret, new_dn, new_conv = [], [], []
    for l in range(DEPTH):
        lw = [wt[l] for wt in layer_weights]
        h, sr, sd, cb = _layer(h, p[l], conv_bufs[l], s_rets[l], s_dns[l], pos0, *lw)
        new_ret.append(sr)
        new_dn.append(sd)
        new_conv.append(cb)
    y = _rmsnorm(h, final_norm_g)
    return y, jnp.stack(new_ret), jnp.stack(new_dn), jnp.stack(new_conv)


def setup_inputs(seed: int = 0) -> dict:
    key = jax.random.key(seed)
    ks = jax.random.split(key, 24)
    f32 = jnp.float32

    def nrm(k, shape, scale):
        return jax.random.normal(k, shape, f32) * scale

    x_prompt = nrm(ks[0], (BATCH, SEQ, D_MODEL), 1.0)
    x_sample = nrm(ks[1], (DEC_BATCH, DEC_SEQ, D_MODEL), 1.0)
    p_prompt = nrm(ks[2], (DEPTH, BATCH, SEQ, PLE_DIM), 1.0)
    p_sample = nrm(ks[3], (DEPTH, DEC_BATCH, DEC_SEQ, PLE_DIM), 1.0)
    state_ret = nrm(ks[4], (DEPTH, DEC_BATCH, RET_HEADS, RET_DK, RET_DV), 0.1)
    state_delta = nrm(ks[5], (DEPTH, DEC_BATCH, DN_HEADS, DN_DK, DN_DV), 0.1)
    state_conv = nrm(ks[6], (DEPTH, DEC_BATCH, CONV_W - 1, DN_CONV_CH), 1.0)
    norm1_g = 1.0 + nrm(ks[7], (DEPTH, D_MODEL), 0.02)
    w_in = nrm(ks[8], (DEPTH, D_MODEL, IN_COLS), D_MODEL ** -0.5)
    conv_w = nrm(ks[9], (DEPTH, CONV_W, DN_CONV_CH), CONV_W ** -0.5)
    dt = jnp.exp(jax.random.uniform(ks[10], (DEPTH, DN_HEADS), f32, np.log(1e-3), np.log(1e-1)))
    dt_bias = dt + jnp.log(-jnp.expm1(-dt))
    a_log = jnp.log(jax.random.uniform(ks[11], (DEPTH, DN_HEADS), f32, 1.0, 16.0))
    ret_norm_g = 1.0 + nrm(ks[12], (DEPTH, RET_W), 0.02)
    dn_norm_g = 1.0 + nrm(ks[13], (DEPTH, DN_DV), 0.02)
    w_out = nrm(ks[14], (DEPTH, MIX_W, D_MODEL), MIX_W ** -0.5)
    norm2_g = 1.0 + nrm(ks[15], (DEPTH, D_MODEL), 0.02)
    w_up = nrm(ks[16], (DEPTH, D_MODEL, D_FF), D_MODEL ** -0.5)
    w_down = nrm(ks[17], (DEPTH, D_FF, D_MODEL), D_FF ** -0.5)
    ple_proj = nrm(ks[18], (DEPTH, PLE_DIM, D_MODEL), PLE_DIM ** -0.5)
    ple_norm_g = 1.0 + nrm(ks[19], (DEPTH, D_MODEL), 0.02)
    ple_gate_w = nrm(ks[20], (DEPTH, D_MODEL, D_MODEL), D_MODEL ** -0.5)
    ple_gate_b = nrm(ks[21], (DEPTH, D_MODEL), 0.01)
    final_norm_g = 1.0 + nrm(ks[22], (D_MODEL,), 0.02)
    return {'x_prompt': x_prompt, 'x_sample': x_sample, 'p_prompt': p_prompt, 'p_sample': p_sample,
            'state_ret': state_ret, 'state_delta': state_delta, 'state_conv': state_conv,
            'norm1_g': norm1_g, 'w_in': w_in, 'conv_w': conv_w, 'dt_bias': dt_bias, 'a_log': a_log,
            'ret_norm_g': ret_norm_g, 'dn_norm_g': dn_norm_g, 'w_out': w_out, 'norm2_g': norm2_g,
            'w_up': w_up, 'w_down': w_down, 'ple_proj': ple_proj, 'ple_norm_g': ple_norm_g,
            'ple_gate_w': ple_gate_w, 'ple_gate_b': ple_gate_b, 'final_norm_g': final_norm_g}


def reference(x_prompt, x_sample, p_prompt, p_sample, state_ret, state_delta, state_conv,
              norm1_g, w_in, conv_w, dt_bias, a_log, ret_norm_g, dn_norm_g, w_out, norm2_g,
              w_up, w_down, ple_proj, ple_norm_g, ple_gate_w, ple_gate_b, final_norm_g):
    layer_weights = (norm1_g, w_in, conv_w, dt_bias, a_log, ret_norm_g, dn_norm_g, w_out, norm2_g,
                     w_up, w_down, ple_proj, ple_norm_g, ple_gate_w, ple_gate_b)
    bp = x_prompt.shape[0]
    dt_ = x_prompt.dtype
    zero_ret = jnp.zeros((DEPTH, bp, RET_HEADS, RET_DK, RET_DV), dt_)
    zero_dn = jnp.zeros((DEPTH, bp, DN_HEADS, DN_DK, DN_DV), dt_)
    zero_conv = jnp.zeros((DEPTH, bp, CONV_W - 1, DN_CONV_CH), dt_)
    y_prompt, ret_p, dn_p, conv_p = _trunk(x_prompt, p_prompt, zero_conv, zero_ret, zero_dn, 0,
                                           layer_weights, final_norm_g)
    y_sample, ret_s, dn_s, conv_s = _trunk(x_sample, p_sample, state_conv, state_ret, state_delta, PAST_LEN,
                                           layer_weights, final_norm_g)
    return (y_prompt, y_sample, ret_p, dn_p, conv_p, ret_s, dn_s, conv_s)
```

```cpp
#include <hip/hip_runtime.h>
#include <hip/hip_bf16.h>
#include <hip/hip_cooperative_groups.h>
#include <cstdio>
namespace cg = cooperative_groups;

typedef unsigned short u16;
using bf16x8 = __attribute__((ext_vector_type(8))) short;
using bf16x4 = __attribute__((ext_vector_type(4))) short;
using f32x4 = __attribute__((ext_vector_type(4))) float;
using f32x16 = __attribute__((ext_vector_type(16))) float;
#define DEVI __device__ __forceinline__

constexpr int NTOK = 18432, NPR = 16384, DM = 1024, ZC = 4096;
constexpr int NTHR = 256;
constexpr int LDS_BYTES = 73728;
constexpr float EPS = 1e-6f;

constexpr size_t WT_IN = 0, WT_OUT = 4194304, WT_UP = 5242880, WT_DOWN = 9437184, WT_PROJ = 13631488,
                 WT_GATE = 13893632, WT_END = 14942208;
constexpr size_t OFF_WSM = WT_END * 2;
constexpr size_t OFF_XN = OFF_WSM + 65536;
constexpr size_t OFF_Z = OFF_XN + 37748736;
constexpr size_t OFF_UTD = OFF_Z + 150994944;
constexpr size_t OFF_ATT = OFF_UTD + 18874368;
constexpr size_t OFF_ZB = OFF_ATT + 18874368;
constexpr size_t OFF_ZS = OFF_ZB + 2654208;
constexpr size_t OFF_GE = OFF_ZS + 589824;
constexpr size_t O_RETP = 18874368, O_DNP = 19136512, O_CONVP = 19398656, O_RETS = 19417088,
                 O_DNS = 23611392, O_CONVS = 27805696;

struct Params {
  const float *x_prompt, *x_sample, *p_prompt, *p_sample, *state_ret, *state_delta, *state_conv;
  const float *norm1_g, *w_in, *conv_w, *dt_bias, *a_log, *ret_norm_g, *dn_norm_g, *w_out, *norm2_g, *w_up,
      *w_down, *ple_proj, *ple_norm_g, *ple_gate_w, *ple_gate_b, *final_norm_g;
  float* out;
  char* ws;
  int phase_lo, phase_hi, coop, pad;
};

extern __shared__ __attribute__((aligned(16))) char smem[];

DEVI int otid() {
  int t = threadIdx.x;
  asm volatile("" : "+v"(t));
  return t;
}
DEVI u16 f2bf(float f) {
  unsigned u = __float_as_uint(f);
  u += 0x7fffu + ((u >> 16) & 1u);
  return (u16)(u >> 16);
}
DEVI float bf2f(u16 h) { return __uint_as_float(((unsigned)h) << 16); }
DEVI float bfs(short h) { return __uint_as_float(((unsigned)(u16)h) << 16); }
DEVI float wave_sum(float v) {
#pragma unroll
  for (int o = 32; o > 0; o >>= 1) v += __shfl_xor(v, o);
  return v;
}
DEVI float sigmoidf_(float x) { return 1.f / (1.f + __expf(-x)); }
DEVI f32x16 mfma32(bf16x8 a, bf16x8 b, f32x16 c) { return __builtin_amdgcn_mfma_f32_32x32x16_bf16(a, b, c, 0, 0, 0); }
DEVI f32x4 mfma16(bf16x8 a, bf16x8 b, f32x4 c) { return __builtin_amdgcn_mfma_f32_16x16x32_bf16(a, b, c, 0, 0, 0); }
DEVI bf16x4 pack4(float a, float b, float c, float d) {
  bf16x4 r;
  r[0] = (short)f2bf(a); r[1] = (short)f2bf(b); r[2] = (short)f2bf(c); r[3] = (short)f2bf(d);
  return r;
}

DEVI void cvt_tile(const float* __restrict__ W, int ldn, int k0, int n0, u16* __restrict__ Wt, int ldk) {
  float* tile = (float*)smem;
  const int tid = otid();
#pragma unroll
  for (int i = 0; i < 4; i++) {
    int kk = (tid >> 4) + 16 * i, n4 = (tid & 15) * 4;
    float4 v = *(const float4*)(W + (size_t)(k0 + kk) * ldn + n0 + n4);
    tile[kk * 65 + n4] = v.x; tile[kk * 65 + n4 + 1] = v.y; tile[kk * 65 + n4 + 2] = v.z; tile[kk * 65 + n4 + 3] = v.w;
  }
  __syncthreads();
  int n = tid >> 2, ks = (tid & 3) * 16;
  bf16x8 o0, o1;
#pragma unroll
  for (int e = 0; e < 8; e++) {
    o0[e] = (short)f2bf(tile[(ks + e) * 65 + n]);
    o1[e] = (short)f2bf(tile[(ks + 8 + e) * 65 + n]);
  }
  u16* dst = Wt + (size_t)(n0 + n) * ldk + k0 + ks;
  *(bf16x8*)dst = o0;
  *(bf16x8*)(dst + 8) = o1;
  __syncthreads();
}

__device__ void convert_weights(const Params& p, int l) {
  u16* WT = (u16*)p.ws;
  const int G = gridDim.x;
  for (int t = blockIdx.x; t < 3648; t += G) {
    if (t < 1024) {
      cvt_tile(p.w_in + (size_t)l * 1024 * 4104, 4104, (t >> 6) * 64, (t & 63) * 64, WT + WT_IN, 1024);
    } else if (t < 1280) {
      int u = t - 1024;
      cvt_tile(p.w_out + (size_t)l * 1048576, 1024, (u >> 4) * 64, (u & 15) * 64, WT + WT_OUT, 1024);
    } else if (t < 2304) {
      int u = t - 1280;
      cvt_tile(p.w_up + (size_t)l * 4194304, 4096, (u >> 6) * 64, (u & 63) * 64, WT + WT_UP, 1024);
    } else if (t < 3328) {
      int u = t - 2304;
      cvt_tile(p.w_down + (size_t)l * 4194304, 1024, (u >> 4) * 64, (u & 15) * 64, WT + WT_DOWN, 4096);
    } else if (t < 3392) {
      int u = t - 3328;
      cvt_tile(p.ple_proj + (size_t)l * 262144, 1024, (u >> 4) * 64, (u & 15) * 64, WT + WT_PROJ, 256);
    } else {
      int u = t - 3392;
      cvt_tile(p.ple_gate_w + (size_t)l * 1048576, 1024, (u >> 4) * 64, (u & 15) * 64, WT + WT_GATE, 1024);
    }
  }
  if (l == 0) {
    float* wsm = (float*)(p.ws + OFF_WSM);
    for (int i = blockIdx.x * NTHR + otid(); i < 16384; i += G * NTHR) {
      int ll = i >> 13, j = (i >> 10) & 7, k = i & 1023;
      wsm[i] = p.w_in[(size_t)ll * 1024 * 4104 + (size_t)k * 4104 + 4096 + j];
    }
  }
}

template <int MODE>
__device__ void norm_phase(const Params& p, int l, const float* __restrict__ gain) {
  const int tid = otid();
  const int lane = tid & 63, w = tid >> 6;
  float* H = p.out;
  u16* XN = (u16*)(p.ws + OFF_XN);
  const float* wsm = (const float*)(p.ws + OFF_WSM) + (size_t)l * 8192;
  float* ZS = (float*)(p.ws + OFF_ZS);
  for (int row = blockIdx.x * 4 + w; row < NTOK; row += gridDim.x * 4) {
    const float* src;
    if (MODE == 0) src = row < NPR ? p.x_prompt + (size_t)row * DM : p.x_sample + (size_t)(row - NPR) * DM;
    else src = H + (size_t)row * DM;
    float4 v[4];
    float ss = 0.f;
#pragma unroll
    for (int i = 0; i < 4; i++) {
      v[i] = *(const float4*)(src + i * 256 + lane * 4);
      ss += v[i].x * v[i].x + v[i].y * v[i].y + v[i].z * v[i].z + v[i].w * v[i].w;
    }
    ss = wave_sum(ss);
    float rstd = rsqrtf(ss * (1.f / 1024.f) + EPS);
    float4 y[4];
#pragma unroll
    for (int i = 0; i < 4; i++) {
      float4 g = *(const float4*)(gain + i * 256 + lane * 4);
      y[i].x = v[i].x * rstd * g.x; y[i].y = v[i].y * rstd * g.y; y[i].z = v[i].z * rstd * g.z; y[i].w = v[i].w * rstd * g.w;
    }
    if (MODE == 4) {
#pragma unroll
      for (int i = 0; i < 4; i++) *(float4*)(H + (size_t)row * DM + i * 256 + lane * 4) = y[i];
    } else {
#pragma unroll
      for (int i = 0; i < 4; i++)
        *(bf16x4*)(XN + (size_t)row * DM + i * 256 + lane * 4) = pack4(y[i].x, y[i].y, y[i].z, y[i].w);
    }
    if (MODE == 0) {
#pragma unroll
      for (int i = 0; i < 4; i++) *(float4*)(H + (size_t)row * DM + i * 256 + lane * 4) = v[i];
    }
    if (MODE == 0 || MODE == 1) {
      float d[8];
#pragma unroll
      for (int j = 0; j < 8; j++) {
        float a = 0.f;
#pragma unroll
        for (int i = 0; i < 4; i++) {
          float4 wv = *(const float4*)(wsm + j * 1024 + i * 256 + lane * 4);
          a += y[i].x * wv.x + y[i].y * wv.y + y[i].z * wv.z + y[i].w * wv.w;
        }
        d[j] = wave_sum(a);
      }
      if (lane == 0) {
        *(float4*)(ZS + (size_t)row * 8) = make_float4(d[0], d[1], d[2], d[3]);
        *(float4*)(ZS + (size_t)row * 8 + 4) = make_float4(d[4], d[5], d[6], d[7]);
      }
    }
    if (MODE == 3) {
      u16* PB = (u16*)(p.ws + OFF_Z);
      const float* ps = row < NPR ? p.p_prompt + ((size_t)l * NPR + row) * 256
                                  : p.p_sample + ((size_t)l * 2048 + (row - NPR)) * 256;
      float4 pv = *(const float4*)(ps + lane * 4);
      *(bf16x4*)(PB + (size_t)row * 256 + lane * 4) = pack4(pv.x, pv.y, pv.z, pv.w);
    }
  }
}

DEVI int lds_byte(int r, int c) {
  int st = (r >> 4) * 2 + (c >> 5), rr = r & 15, cc = c & 31, ob = rr * 64 + cc * 2;
  return st * 1024 + (ob ^ (((ob >> 9) & 1) << 5));
}
DEVI void stage_rc(int b, int& R, int& C) {
  int st = b / 1024, sb = b % 1024, swz = sb ^ (((sb >> 9) & 1) << 5);
  R = (st >> 1) * 16 + swz / 64;
  C = (st & 1) * 32 + (swz % 64) / 2;
}

DEVI void gemm_kloop(f32x4 (&acc)[4][4], const u16* __restrict__ A, int lda, const u16* __restrict__ Bt, int ldb,
                     int brow, int bcol, int K) {
  const int tid = otid(), lane = tid & 63, wid = tid >> 6, wr = wid >> 1, wc = wid & 1, fr = lane & 15,
            fq = lane >> 4;
  const int nt = K / 64;
  int sr[4], sc[4];
#pragma unroll
  for (int i = 0; i < 4; i++) stage_rc(tid * 16 + i * 4096, sr[i], sc[i]);
  const u16* Ab = A + (size_t)brow * lda;
  const u16* Bb = Bt + (size_t)bcol * ldb;
#define GSTAGE(buf, kt)                                                                                         \
  do {                                                                                                          \
    _Pragma("unroll") for (int i = 0; i < 4; i++) {                                                             \
      int b_ = tid * 16 + i * 4096;                                                                             \
      __builtin_amdgcn_global_load_lds((const unsigned*)(Ab + (size_t)sr[i] * lda + (kt) * 64 + sc[i]),         \
                                       (unsigned*)(smem + (buf) * 32768 + b_), 16, 0, 0);                       \
      __builtin_amdgcn_global_load_lds((const unsigned*)(Bb + (size_t)sr[i] * ldb + (kt) * 64 + sc[i]),         \
                                       (unsigned*)(smem + (buf) * 32768 + 16384 + b_), 16, 0, 0);               \
    }                                                                                                           \
  } while (0)
  GSTAGE(0, 0);
  for (int t = 0; t < nt; t++) {
    asm volatile("s_waitcnt vmcnt(0)" ::: "memory");
    __syncthreads();
    if (t + 1 < nt) GSTAGE((t + 1) & 1, t + 1);
    const char* sa = smem + (t & 1) * 32768;
    const char* sb = sa + 16384;
    bf16x8 af[4][2], bf[4][2];
#pragma unroll
    for (int m = 0; m < 4; m++)
#pragma unroll
      for (int k = 0; k < 2; k++) af[m][k] = *(const bf16x8*)(sa + lds_byte(wr * 64 + m * 16 + fr, k * 32 + fq * 8));
#pragma unroll
    for (int n = 0; n < 4; n++)
#pragma unroll
      for (int k = 0; k < 2; k++) bf[n][k] = *(const bf16x8*)(sb + lds_byte(wc * 64 + n * 16 + fr, k * 32 + fq * 8));
#pragma unroll
    for (int k = 0; k < 2; k++)
#pragma unroll
      for (int m = 0; m < 4; m++)
#pragma unroll
        for (int n = 0; n < 4; n++) acc[m][n] = mfma16(bf[n][k], af[m][k], acc[m][n]);
  }
  __syncthreads();
#undef GSTAGE
}

template <int EPI>
__device__ void gemm_phase(const Params& p, int l, const u16* A, int lda, const u16* Bt, int ldb, int N, int K) {
  const int tid = otid(), lane = tid & 63, wid = tid >> 6, wr = wid >> 1, wc = wid & 1, fr = lane & 15,
            fq = lane >> 4;
  const int nN = N / 128, ntile = (NTOK / 128) * nN;
  u16* Z = (u16*)(p.ws + OFF_Z);
  float* H = p.out;
  for (int t = blockIdx.x; t < ntile; t += gridDim.x) {
    const int tn = t % nN, tm = t / nN;
    const int brow = tm * 128, bcol = tn * 128;
    f32x4 acc[4][4];
#pragma unroll
    for (int m = 0; m < 4; m++)
#pragma unroll
      for (int n = 0; n < 4; n++) acc[m][n] = f32x4{0.f, 0.f, 0.f, 0.f};
    if (EPI != 3) gemm_kloop(acc, A, lda, Bt, ldb, brow, bcol, K);
    if (EPI == 3) {
      bf16x4 pp[4][4];
      gemm_kloop(acc, (const u16*)(p.ws + OFF_Z), 256, (const u16*)p.ws + WT_PROJ, 256, brow, bcol, 256);
#pragma unroll
      for (int m = 0; m < 4; m++)
#pragma unroll
        for (int n = 0; n < 4; n++) {
          pp[m][n] = pack4(acc[m][n][0], acc[m][n][1], acc[m][n][2], acc[m][n][3]);
          acc[m][n] = f32x4{0.f, 0.f, 0.f, 0.f};
        }
      gemm_kloop(acc, A, lda, Bt, ldb, brow, bcol, K);
#pragma unroll
      for (int m = 0; m < 4; m++)
#pragma unroll
        for (int n = 0; n < 4; n++) {
          int row = brow + wr * 64 + m * 16 + fr, col = bcol + wc * 64 + n * 16 + fq * 4;
          float4 b = *(const float4*)(p.ple_gate_b + (size_t)l * 1024 + col);
          float4* hp = (float4*)(H + (size_t)row * DM + col);
          float4 hv = *hp;
          hv.x += bfs(pp[m][n][0]) * sigmoidf_(acc[m][n][0] + b.x);
          hv.y += bfs(pp[m][n][1]) * sigmoidf_(acc[m][n][1] + b.y);
          hv.z += bfs(pp[m][n][2]) * sigmoidf_(acc[m][n][2] + b.z);
          hv.w += bfs(pp[m][n][3]) * sigmoidf_(acc[m][n][3] + b.w);
          *hp = hv;
        }
    } else {
#pragma unroll
      for (int m = 0; m < 4; m++)
#pragma unroll
        for (int n = 0; n < 4; n++) {
          int row = brow + wr * 64 + m * 16 + fr, col = bcol + wc * 64 + n * 16 + fq * 4;
          f32x4 a = acc[m][n];
          if (EPI == 0) {
            bf16x4 zb4 = pack4(a[0], a[1], a[2], a[3]);
            *(bf16x4*)(Z + (size_t)row * ZC + col) = zb4;
            int rr = (row & 63) - 61;
            if (rr >= 0 && col >= 2048 && col < 3584) {
              u16* ZB = (u16*)(p.ws + OFF_ZB);
              int ch = col - 2048;
              *(bf16x4*)(ZB + ((size_t)(row >> 6) * 3 + rr) * 1536 + ch) = zb4;
              if (row >= NPR) {
                int b = (row - NPR) >> 6;
                *(float4*)(p.out + O_CONVS + (((size_t)l * 32 + b) * 3 + rr) * 1536 + ch) = make_float4(a[0], a[1], a[2], a[3]);
              } else if ((row & 8191) >= 8189) {
                int b = row >> 13;
                *(float4*)(p.out + O_CONVP + (((size_t)l * 2 + b) * 3 + rr) * 1536 + ch) = make_float4(a[0], a[1], a[2], a[3]);
              }
            }
          } else if (EPI == 1) {
            float4* hp = (float4*)(H + (size_t)row * DM + col);
            float4 hv = *hp;
            hv.x += a[0]; hv.y += a[1]; hv.z += a[2]; hv.w += a[3];
            *hp = hv;
          } else if (EPI == 2) {
            float r0 = fmaxf(a[0], 0.f), r1 = fmaxf(a[1], 0.f), r2 = fmaxf(a[2], 0.f), r3 = fmaxf(a[3], 0.f);
            *(bf16x4*)(Z + (size_t)row * ZC + col) = pack4(r0 * r0, r1 * r1, r2 * r2, r3 * r3);
          }
        }
    }
  }
}

constexpr int LP = 136;

__device__ void c2_ret(const Params& p, int l, int chunk, int h) {
  u16* Z = (u16*)(p.ws + OFF_Z);
  u16* ATT = (u16*)(p.ws + OFF_ATT);
  int tid_ = threadIdx.x;
  asm volatile("" : "+v"(tid_));
  const int tid = tid_, lane = tid & 63, w = __builtin_amdgcn_readfirstlane(tid >> 6), r = lane & 31, hh = lane >> 5;
  u16* qs = (u16*)smem;
  u16* ks = qs + 64 * LP;
  u16* vs = ks + 64 * LP;
  const int row0 = chunk * 64;
  const bool is_sample = chunk >= 256;
  const int pos0 = is_sample ? 4096 : (chunk & 127) * 64;
  const float lg2 = log2f(1.f - exp2f(-5.f - (float)h));
  const int cq = h * 128, ck = 512 + h * 128, cv = 1024 + h * 128;
#pragma unroll 1
  for (int it = 0; it < 2; it++) {
    int item = it * 256 + tid;
    int t = item >> 3, cg8 = (item & 7) * 8;
    size_t zr = (size_t)(row0 + t) * ZC;
    bf16x8 q1 = *(const bf16x8*)(Z + zr + cq + cg8), q2 = *(const bf16x8*)(Z + zr + cq + 64 + cg8);
    bf16x8 k1 = *(const bf16x8*)(Z + zr + ck + cg8), k2 = *(const bf16x8*)(Z + zr + ck + 64 + cg8);
    float pos = (float)(pos0 + t);
    float cross = exp2f(lg2 * (float)(t + 1));
    bf16x8 oq1, oq2, sq1, sq2, sk1, sk2;
#pragma unroll
    for (int e = 0; e < 8; e++) {
      int d = cg8 + e;
      float inv = exp2f(-(float)d * (13.287712379549449f / 64.f));
      float ang = pos * inv;
      float sn = sinf(ang), cs = cosf(ang);
      float a = bfs(q1[e]), b = bfs(q2[e]);
      float qa = a * cs - b * sn, qb = a * sn + b * cs;
      sq1[e] = (short)f2bf(qa); sq2[e] = (short)f2bf(qb);
      oq1[e] = (short)f2bf(qa * cross); oq2[e] = (short)f2bf(qb * cross);
      a = bfs(k1[e]); b = bfs(k2[e]);
      float ka = (a * cs - b * sn) * 0.08838834764831845f, kb = (a * sn + b * cs) * 0.08838834764831845f;
      sk1[e] = (short)f2bf(ka); sk2[e] = (short)f2bf(kb);
    }
    *(bf16x8*)(qs + t * LP + cg8) = sq1; *(bf16x8*)(qs + t * LP + 64 + cg8) = sq2;
    *(bf16x8*)(ks + t * LP + cg8) = sk1; *(bf16x8*)(ks + t * LP + 64 + cg8) = sk2;
    *(bf16x8*)(Z + zr + cq + cg8) = oq1; *(bf16x8*)(Z + zr + cq + 64 + cg8) = oq2;
  }
#pragma unroll 1
  for (int it = 0; it < 4; it++) {
    int item = it * 256 + tid;
    int t = item >> 4, c8 = (item & 15) * 8;
    *(bf16x8*)(vs + t * LP + c8) = *(const bf16x8*)(Z + (size_t)(row0 + t) * ZC + cv + c8);
  }
  __syncthreads();
  {
    const int ib = w & 1, jb = w >> 1;
    f32x16 acc;
#pragma unroll
    for (int e = 0; e < 16; e++) acc[e] = 0.f;
#pragma unroll
    for (int kk = 0; kk < 8; kk++) {
      bf16x8 a = *(const bf16x8*)(ks + (jb * 32 + r) * LP + kk * 16 + hh * 8);
      bf16x8 b = *(const bf16x8*)(qs + (ib * 32 + r) * LP + kk * 16 + hh * 8);
      acc = mfma32(a, b, acc);
    }
    const int i = ib * 32 + r;
    u16* att = ATT + (size_t)(chunk * 4 + h) * 4096;
#pragma unroll
    for (int g = 0; g < 4; g++) {
      int j0 = jb * 32 + 8 * g + 4 * hh;
      float o[4];
#pragma unroll
      for (int e = 0; e < 4; e++) {
        int dj = i - (j0 + e);
        dj = dj < 0 ? -dj : dj;
        o[e] = acc[4 * g + e] * exp2f(lg2 * (float)dj);
      }
      *(bf16x4*)(att + i * 64 + j0) = pack4(o[0], o[1], o[2], o[3]);
    }
  }
  {
    const int d = tid & 127, half = tid >> 7;
#pragma unroll
    for (int q4 = 0; q4 < 4; q4++) {
      bf16x8 ok, ov;
#pragma unroll
      for (int e = 0; e < 8; e++) {
        int tt = half * 32 + q4 * 8 + e;
        ok[e] = (short)f2bf(bf2f(ks[tt * LP + d]) * exp2f(lg2 * (float)(63 - tt)));
        ov[e] = (short)vs[tt * LP + d];
      }
      size_t base = (size_t)(row0 + (d >> 1)) * ZC + (d & 1) * 64 + half * 32 + q4 * 8;
      *(bf16x8*)(Z + base + ck) = ok;
      *(bf16x8*)(Z + base + cv) = ov;
    }
  }
  __syncthreads();
}

__device__ void c2_delta(const Params& p, int l, int chunk, int h) {
  u16* Z = (u16*)(p.ws + OFF_Z);
  u16* ATT = (u16*)(p.ws + OFF_ATT);
  u16* UTD = (u16*)(p.ws + OFF_UTD);
  const u16* ZB = (const u16*)(p.ws + OFF_ZB);
  const float* ZS = (const float*)(p.ws + OFF_ZS);
  float* GE = (float*)(p.ws + OFF_GE);
  int tid_ = threadIdx.x;
  asm volatile("" : "+v"(tid_));
  const int tid = tid_, lane = tid & 63, w = __builtin_amdgcn_readfirstlane(tid >> 6), r = lane & 31, hh = lane >> 5;
  u16* qs = (u16*)smem;
  u16* ks = qs + 64 * LP;
  u16* vs = ks + 64 * LP;
  float* Af = (float*)(vs + 64 * LP);
  float* gcs = Af + 4096;
  float* su = gcs + 64;
  float* sw = su + 64;
  float* egq = sw + 64;
  float* egk = egq + 64;
  const int row0 = chunk * 64;
  const bool is_sample = chunk >= 256;
  const int nseq = is_sample ? 0 : (chunk & 127);
  const int sb = chunk - 256;
#pragma unroll 1
  for (int it = 0; it < 12; it++) {
    const int part = it >> 2;
    const int t = (((it & 3) << 8) + tid) >> 4, cg8 = (tid & 15) * 8;
    const int ch = part * 512 + h * 128 + cg8;
    float a[8];
#pragma unroll
    for (int e = 0; e < 8; e++) a[e] = 0.f;
#pragma unroll
    for (int i = 0; i < 4; i++) {
      int tt = t + i - 3;
      float xv[8];
      if (tt >= 0) {
        bf16x8 v = *(const bf16x8*)(Z + (size_t)(row0 + tt) * ZC + 2048 + ch);
#pragma unroll
        for (int e = 0; e < 8; e++) xv[e] = bfs(v[e]);
      } else if (is_sample) {
        const float* s = p.state_conv + (((size_t)l * 32 + sb) * 3 + (tt + 3)) * 1536 + ch;
        float4 s0 = *(const float4*)s, s1 = *(const float4*)(s + 4);
        xv[0] = s0.x; xv[1] = s0.y; xv[2] = s0.z; xv[3] = s0.w; xv[4] = s1.x; xv[5] = s1.y; xv[6] = s1.z; xv[7] = s1.w;
      } else if (nseq > 0) {
        bf16x8 v = *(const bf16x8*)(ZB + ((size_t)(chunk - 1) * 3 + (tt + 3)) * 1536 + ch);
#pragma unroll
        for (int e = 0; e < 8; e++) xv[e] = bfs(v[e]);
      } else {
#pragma unroll
        for (int e = 0; e < 8; e++) xv[e] = 0.f;
      }
      const float* cw = p.conv_w + ((size_t)l * 4 + i) * 1536 + ch;
      float4 w0 = *(const float4*)cw, w1 = *(const float4*)(cw + 4);
      a[0] += xv[0] * w0.x; a[1] += xv[1] * w0.y; a[2] += xv[2] * w0.z; a[3] += xv[3] * w0.w;
      a[4] += xv[4] * w1.x; a[5] += xv[5] * w1.y; a[6] += xv[6] * w1.z; a[7] += xv[7] * w1.w;
    }
    float ss = 0.f;
#pragma unroll
    for (int e = 0; e < 8; e++) {
      a[e] = a[e] * sigmoidf_(a[e]);
      ss += a[e] * a[e];
    }
    if (part < 2) {
      ss += __shfl_xor(ss, 1); ss += __shfl_xor(ss, 2); ss += __shfl_xor(ss, 4); ss += __shfl_xor(ss, 8);
      float sc = rsqrtf(ss + EPS) * (part == 0 ? 0.08838834764831845f : 1.f);
#pragma unroll
      for (int e = 0; e < 8; e++) a[e] *= sc;
    }
    bf16x8 o;
#pragma unroll
    for (int e = 0; e < 8; e++) o[e] = (short)f2bf(a[e]);
    u16* dst = part == 0 ? qs : (part == 1 ? ks : vs);
    *(bf16x8*)(dst + t * LP + cg8) = o;
  }
  if (w == 0) {
    const int row = row0 + lane;
    float bb = ZS[(size_t)row * 8 + h], ab = ZS[(size_t)row * 8 + 4 + h];
    float beta = sigmoidf_(bb);
    float x = ab + p.dt_bias[l * 4 + h];
    float sp = x > 20.f ? x : log1pf(expf(x));
    float gc = -expf(p.a_log[l * 4 + h]) * sp;
#pragma unroll
    for (int o = 1; o < 64; o <<= 1) {
      float v = __shfl_up(gc, o);
      if (lane >= o) gc += v;
    }
    float gl = __shfl(gc, 63);
    gcs[lane] = gc;
    su[lane] = beta;
    sw[lane] = beta * expf(gc);
    egq[lane] = expf(gc);
    egk[lane] = expf(gl - gc);
    if (lane == 63) GE[chunk * 4 + h] = expf(gc);
  }
  __syncthreads();
  {
    const int ib = w & 1, jb = w >> 1;
    const int i = ib * 32 + r;
    u16* att = ATT + (size_t)(1152 + chunk * 4 + h) * 4096;
    if (jb <= ib) {
      f32x16 aK, aQ;
#pragma unroll
      for (int e = 0; e < 16; e++) { aK[e] = 0.f; aQ[e] = 0.f; }
#pragma unroll
      for (int kk = 0; kk < 8; kk++) {
        bf16x8 a = *(const bf16x8*)(ks + (jb * 32 + r) * LP + kk * 16 + hh * 8);
        bf16x8 bk = *(const bf16x8*)(ks + (ib * 32 + r) * LP + kk * 16 + hh * 8);
        bf16x8 bq = *(const bf16x8*)(qs + (ib * 32 + r) * LP + kk * 16 + hh * 8);
        aK = mfma32(a, bk, aK);
        aQ = mfma32(a, bq, aQ);
      }
      const float gi = gcs[i], bi = su[i];
#pragma unroll
      for (int g = 0; g < 4; g++) {
        int j0 = jb * 32 + 8 * g + 4 * hh;
        float oa[4], oq[4];
#pragma unroll
        for (int e = 0; e < 4; e++) {
          int j = j0 + e;
          float dec = (i >= j) ? expf(gi - gcs[j]) : 0.f;
          oa[e] = (i > j) ? aK[4 * g + e] * bi * dec : 0.f;
          oq[e] = aQ[4 * g + e] * dec;
        }
        *(float4*)(Af + i * 64 + j0) = make_float4(oa[0], oa[1], oa[2], oa[3]);
        *(bf16x4*)(att + i * 64 + j0) = pack4(oq[0], oq[1], oq[2], oq[3]);
      }
    } else {
#pragma unroll
      for (int g = 0; g < 4; g++) {
        int j0 = jb * 32 + 8 * g + 4 * hh;
        *(float4*)(Af + i * 64 + j0) = make_float4(0.f, 0.f, 0.f, 0.f);
        *(bf16x4*)(att + i * 64 + j0) = bf16x4{0, 0, 0, 0};
      }
    }
  }
  __syncthreads();
  {
#pragma unroll 1
    for (int it = 0; it < 4; it++) {
      int item = it * 256 + tid;
      int t = item >> 4, c8 = (item & 15) * 8;
      bf16x8 v = *(const bf16x8*)(qs + t * LP + c8);
      float sc = egq[t];
      bf16x8 o;
#pragma unroll
      for (int e = 0; e < 8; e++) o[e] = (short)f2bf(bfs(v[e]) * sc);
      *(bf16x8*)(Z + (size_t)(row0 + t) * ZC + 2560 + h * 128 + c8) = o;
    }
    const int d = tid & 127, half = tid >> 7;
#pragma unroll
    for (int q4 = 0; q4 < 4; q4++) {
      bf16x8 ok;
#pragma unroll
      for (int e = 0; e < 8; e++) {
        int tt = half * 32 + q4 * 8 + e;
        ok[e] = (short)f2bf(bf2f(ks[tt * LP + d]) * egk[tt]);
      }
      size_t base = (size_t)(row0 + (d >> 1)) * ZC + 3072 + h * 128 + (d & 1) * 64 + half * 32 + q4 * 8;
      *(bf16x8*)(Z + base) = ok;
    }
  }
  __syncthreads();
  {
    const int cc = tid & 127;
    const u16* src = (tid < 128) ? vs : ks;
    const float* scl = (tid < 128) ? su : sw;
    float x[64];
    int vzero;
    asm volatile("v_mov_b32 %0, 0" : "=v"(vzero));
    const float* Afv = Af + vzero;
    const float* sclv = scl + vzero;
#pragma unroll
    for (int i = 0; i < 64; i++) {
      float acc = bf2f(src[i * LP + cc]) * sclv[i];
#pragma unroll
      for (int j4 = 0; j4 < (i + 3) / 4; j4++) {
        float4 av = *(const float4*)(Afv + i * 64 + j4 * 4);
        if (j4 * 4 + 0 < i) acc -= av.x * x[j4 * 4 + 0];
        if (j4 * 4 + 1 < i) acc -= av.y * x[j4 * 4 + 1];
        if (j4 * 4 + 2 < i) acc -= av.z * x[j4 * 4 + 2];
        if (j4 * 4 + 3 < i) acc -= av.w * x[j4 * 4 + 3];
      }
      x[i] = acc;
      __builtin_amdgcn_sched_barrier(0);
    }
    if (tid < 128) {
      u16* ut = UTD + ((size_t)(chunk * 4 + h) * 128 + cc) * 64;
#pragma unroll
      for (int q8 = 0; q8 < 8; q8++) {
        bf16x8 o;
#pragma unroll
        for (int e = 0; e < 8; e++) o[e] = (short)f2bf(x[q8 * 8 + e]);
        *(bf16x8*)(ut + q8 * 8) = o;
      }
    } else {
#pragma unroll
      for (int i = 0; i < 64; i++) qs[i * LP + cc] = f2bf(x[i]);
    }
  }
  __syncthreads();
#pragma unroll 1
  for (int it = 0; it < 4; it++) {
    int item = it * 256 + tid;
    int t = item >> 4, c8 = (item & 15) * 8;
    *(bf16x8*)(Z + (size_t)(row0 + t) * ZC + 2048 + h * 128 + c8) = *(const bf16x8*)(qs + t * LP + c8);
  }
  __syncthreads();
}

constexpr int STP = 136, VNP = 72;
__device__ void scan_task(const Params& p, int l, int type, int seq, int h, int s) {
  const u16* Z = (const u16*)(p.ws + OFF_Z);
  const u16* ATT = (const u16*)(p.ws + OFF_ATT);
  const u16* UTD = (const u16*)(p.ws + OFF_UTD);
  const float* GE = (const float*)(p.ws + OFF_GE);
  u16* XN = (u16*)(p.ws + OFF_XN);
  const int tid = otid(), lane = tid & 63, w = __builtin_amdgcn_readfirstlane(tid >> 6), r = lane & 31, hh = lane >> 5;
  u16* ST = (u16*)smem;
  u16* VNT = ST + 32 * STP;
  const int nchunks = seq < 2 ? 128 : 1;
  const int chunk0 = seq < 2 ? seq * 128 : 256 + (seq - 2);
  const int dv0 = s * 32;
  const int c0 = type ? 2048 + h * 128 : h * 128;
  const int c1 = c0 + 512, c2 = c0 + 1024;
  const int colA8 = (w < 2) ? c0 : (type ? c1 : c0);
  const int colKT = type ? c2 : c1;
  const int mb = w & 1;
  const float carry = exp2f(64.f * log2f(1.f - exp2f(-5.f - (float)h)));
  f32x16 S;
  if (seq < 2) {
#pragma unroll
    for (int e = 0; e < 16; e++) S[e] = 0.f;
  } else {
    const float* s0 = (type ? p.state_delta : p.state_ret) + (((size_t)l * 32 + (seq - 2)) * 4 + h) * 16384;
#pragma unroll
    for (int e = 0; e < 16; e++) {
      int dk = w * 32 + (e & 3) + 8 * (e >> 2) + 4 * hh;
      S[e] = s0[(size_t)dk * 128 + dv0 + r];
    }
  }
#pragma unroll
  for (int g = 0; g < 4; g++)
    *(bf16x4*)(ST + r * STP + w * 32 + 8 * g + 4 * hh) = pack4(S[4 * g], S[4 * g + 1], S[4 * g + 2], S[4 * g + 3]);

  bf16x8 F8[8], F4[4], KT[4];
  bf16x4 U4[4];
  float ge = carry;
  const bool needA8 = (w >= 2) || type;
#define LOAD_OPS(chunk)                                                                                        \
  do {                                                                                                         \
    const size_t zr_ = (size_t)(chunk) * 64 * ZC;                                                              \
    if (needA8) {                                                                                              \
      _Pragma("unroll") for (int ks_ = 0; ks_ < 8; ks_++)                                                      \
        F8[ks_] = *(const bf16x8*)(Z + zr_ + (size_t)(mb * 32 + r) * ZC + colA8 + ks_ * 16 + hh * 8);          \
    }                                                                                                          \
    if (w >= 2) {                                                                                              \
      const u16* att_ = ATT + (size_t)(type * 1152 + (chunk) * 4 + h) * 4096;                                  \
      _Pragma("unroll") for (int ks_ = 0; ks_ < 4; ks_++)                                                      \
        F4[ks_] = *(const bf16x8*)(att_ + (mb * 32 + r) * 64 + ks_ * 16 + hh * 8);                             \
    } else {                                                                                                   \
      const int d_ = dv0 + r;                                                                                  \
      const u16* ub_ = type ? UTD + ((size_t)((chunk) * 4 + h) * 128 + d_) * 64                                \
                            : Z + zr_ + (size_t)(d_ >> 1) * ZC + c2 + (d_ & 1) * 64;                           \
      _Pragma("unroll") for (int g_ = 0; g_ < 4; g_++) U4[g_] = *(const bf16x4*)(ub_ + mb * 32 + 8 * g_ + 4 * hh); \
    }                                                                                                          \
    {                                                                                                          \
      const int dk_ = w * 32 + r;                                                                              \
      const u16* kb_ = Z + zr_ + (size_t)(dk_ >> 1) * ZC + colKT + (dk_ & 1) * 64;                             \
      _Pragma("unroll") for (int ks_ = 0; ks_ < 4; ks_++) KT[ks_] = *(const bf16x8*)(kb_ + ks_ * 16 + hh * 8); \
    }                                                                                                          \
    if (type) ge = GE[(chunk) * 4 + h];                                                                        \
  } while (0)

  __syncthreads();
#pragma unroll 1
  for (int n = 0; n < nchunks; n++) {
    const int chunk = chunk0 + n;
    LOAD_OPS(chunk);
    f32x16 acc;
#pragma unroll
    for (int e = 0; e < 16; e++) acc[e] = 0.f;
    if (needA8) {
#pragma unroll
      for (int ks = 0; ks < 8; ks++) {
        bf16x8 b = *(const bf16x8*)(ST + r * STP + ks * 16 + hh * 8);
        acc = mfma32(F8[ks], b, acc);
      }
    }
    if (w < 2) {
#pragma unroll
      for (int g = 0; g < 4; g++) {
        float v0 = bfs(U4[g][0]) - acc[4 * g], v1 = bfs(U4[g][1]) - acc[4 * g + 1], v2 = bfs(U4[g][2]) - acc[4 * g + 2],
              v3 = bfs(U4[g][3]) - acc[4 * g + 3];
        *(bf16x4*)(VNT + r * VNP + mb * 32 + 8 * g + 4 * hh) = pack4(v0, v1, v2, v3);
      }
    }
    __syncthreads();
    bf16x8 vb[4];
#pragma unroll
    for (int ks = 0; ks < 4; ks++) vb[ks] = *(const bf16x8*)(VNT + r * VNP + ks * 16 + hh * 8);
    if (w >= 2) {
#pragma unroll
      for (int ks = 0; ks < 4; ks++) acc = mfma32(F4[ks], vb[ks], acc);
      u16* op = XN + (size_t)(chunk * 64 + mb * 32) * DM + type * 512 + h * 128 + dv0 + r;
#pragma unroll
      for (int e = 0; e < 16; e++) {
        int tok = (e & 3) + 8 * (e >> 2) + 4 * hh;
        op[(size_t)tok * DM] = f2bf(acc[e]);
      }
    }
#pragma unroll
    for (int e = 0; e < 16; e++) S[e] *= ge;
#pragma unroll
    for (int ks = 0; ks < 4; ks++) S = mfma32(KT[ks], vb[ks], S);
#pragma unroll
    for (int g = 0; g < 4; g++)
      *(bf16x4*)(ST + r * STP + w * 32 + 8 * g + 4 * hh) = pack4(S[4 * g], S[4 * g + 1], S[4 * g + 2], S[4 * g + 3]);
    __syncthreads();
  }
#undef LOAD_OPS
  float* so;
  if (seq < 2) so = p.out + (type ? O_DNP : O_RETP) + (((size_t)l * 2 + seq) * 4 + h) * 16384;
  else so = p.out + (type ? O_DNS : O_RETS) + (((size_t)l * 32 + (seq - 2)) * 4 + h) * 16384;
#pragma unroll
  for (int e = 0; e < 16; e++) {
    int dk = w * 32 + (e & 3) + 8 * (e >> 2) + 4 * hh;
    so[(size_t)dk * 128 + dv0 + r] = S[e];
  }
  __syncthreads();
}

__device__ void scan_phase(const Params& p, int l) {
  for (int t = blockIdx.x; t < 1088; t += gridDim.x) {
    if (t < 64) {
      int type = (t < 32) ? 1 : 0;
      int bh = t & 7, s = (t >> 3) & 3;
      scan_task(p, l, type, bh >> 2, bh & 3, s);
    } else {
      int u = t - 64;
      int type = u & 1, s = (u >> 1) & 3, h = (u >> 3) & 3, b = u >> 5;
      scan_task(p, l, type, 2 + b, h, s);
    }
  }
}

__device__ void fin_phase(const Params& p, int l) {
  const int tid = otid();
  const int lane = tid & 63, w = tid >> 6;
  u16* XN = (u16*)(p.ws + OFF_XN);
  const u16* Z = (const u16*)(p.ws + OFF_Z);
  for (int row = blockIdx.x * 4 + w; row < NTOK; row += gridDim.x * 4) {
    u16* op = XN + (size_t)row * DM + lane * 16;
    bf16x8 o0 = *(const bf16x8*)op, o1 = *(const bf16x8*)(op + 8);
    float v[16];
#pragma unroll
    for (int e = 0; e < 8; e++) { v[e] = bfs(o0[e]); v[8 + e] = bfs(o1[e]); }
    const bool ret = lane < 32;
    float s1 = 0.f, s2 = 0.f;
#pragma unroll
    for (int e = 0; e < 16; e++) { s1 += v[e]; s2 += v[e] * v[e]; }
    s1 += __shfl_xor(s1, 1); s1 += __shfl_xor(s1, 2); s1 += __shfl_xor(s1, 4);
    s2 += __shfl_xor(s2, 1); s2 += __shfl_xor(s2, 2); s2 += __shfl_xor(s2, 4);
    float mu = ret ? s1 * (1.f / 128.f) : 0.f;
    float var = s2 * (1.f / 128.f) - mu * mu;
    var = fmaxf(var, 0.f);
    float rstd = rsqrtf(var + EPS);
    const int col = lane * 16;
    const u16* gp = Z + (size_t)row * ZC + (ret ? 1536 + col : 3584 + (col - 512));
    bf16x8 g0 = *(const bf16x8*)gp, g1 = *(const bf16x8*)(gp + 8);
    const float* ng = ret ? p.ret_norm_g + (size_t)l * 512 + col : p.dn_norm_g + (size_t)l * 128 + (col & 127);
    bf16x8 r0, r1;
#pragma unroll
    for (int e = 0; e < 16; e++) {
      float gt = bfs(e < 8 ? g0[e & 7] : g1[e & 7]);
      float y = (v[e] - mu) * rstd * ng[e] * (gt * sigmoidf_(gt));
      if (e < 8) r0[e & 7] = (short)f2bf(y); else r1[e & 7] = (short)f2bf(y);
    }
    *(bf16x8*)op = r0;
    *(bf16x8*)(op + 8) = r1;
  }
}

__global__ void __launch_bounds__(NTHR, 2) fwd_kernel(Params p) {
  const u16* WT = (const u16*)p.ws;
  const u16* XN = (const u16*)(p.ws + OFF_XN);
  const u16* Zc = (const u16*)(p.ws + OFF_Z);
  for (int ph = p.phase_lo; ph < p.phase_hi; ph++) {
    if (ph == 0) {
      convert_weights(p, 0);
    } else if (ph == 23) {
      norm_phase<4>(p, 0, p.final_norm_g);
    } else {
      const int l = (ph - 1) / 11, sub = (ph - 1) % 11;
      switch (sub) {
        case 0:
          if (l == 0) norm_phase<0>(p, l, p.norm1_g);
          else { convert_weights(p, l); norm_phase<1>(p, l, p.norm1_g + (size_t)l * 1024); }
          break;
        case 1: gemm_phase<0>(p, l, XN, 1024, WT + WT_IN, 1024, 4096, 1024); break;
        case 2:
          for (int t = blockIdx.x; t < 2304; t += gridDim.x) {
            int type = t & 1, h = (t >> 1) & 3, chunk = t >> 3;
            if (type) c2_delta(p, l, chunk, h); else c2_ret(p, l, chunk, h);
          }
          break;
        case 3: scan_phase(p, l); break;
        case 4: fin_phase(p, l); break;
        case 5: gemm_phase<1>(p, l, XN, 1024, WT + WT_OUT, 1024, 1024, 1024); break;
        case 6: norm_phase<2>(p, l, p.norm2_g + (size_t)l * 1024); break;
        case 7: gemm_phase<2>(p, l, XN, 1024, WT + WT_UP, 1024, 4096, 1024); break;
        case 8: gemm_phase<1>(p, l, Zc, 4096, WT + WT_DOWN, 4096, 1024, 4096); break;
        case 9: norm_phase<3>(p, l, p.ple_norm_g + (size_t)l * 1024); break;
        case 10: gemm_phase<3>(p, l, XN, 1024, WT + WT_GATE, 1024, 1024, 1024); break;
      }
    }
    if (p.coop && ph + 1 < p.phase_hi) cg::this_grid().sync();
  }
}

extern "C" void kernel_launch(void* const* d_in, const int* in_sizes, int n_in, void* d_out, int out_size, void* d_ws,
                              size_t ws_size, hipStream_t stream) {
  static int grid_blocks = 0;
  if (!grid_blocks) {
    int dev = 0, cus = 0, per_cu = 0;
    hipGetDevice(&dev);
    hipDeviceGetAttribute(&cus, hipDeviceAttributeMultiprocessorCount, dev);
    hipFuncSetAttribute((const void*)fwd_kernel, hipFuncAttributeMaxDynamicSharedMemorySize, LDS_BYTES);
    hipOccupancyMaxActiveBlocksPerMultiprocessor(&per_cu, fwd_kernel, NTHR, LDS_BYTES);
    if (per_cu < 1) per_cu = 1;
    if (per_cu > 2) per_cu = 2;
    grid_blocks = cus * per_cu;
  }
  Params p{};
  const float** f = (const float**)&p;
  for (int i = 0; i < 23; i++) f[i] = (const float*)d_in[i];
  p.out = (float*)d_out;
  p.ws = (char*)d_ws;
  p.pad = 0;
#ifndef ONE_LAUNCH
  p.coop = 0;
  for (int ph = 0; ph < 24; ph++) {
    p.phase_lo = ph;
    p.phase_hi = ph + 1;
    hipLaunchKernelGGL(fwd_kernel, dim3(grid_blocks), dim3(NTHR), LDS_BYTES, stream, p);
  }
#else
  p.coop = 1;
  p.phase_lo = 0;
  p.phase_hi = 24;
  void* args[] = {&p};
  hipError_t e = hipLaunchCooperativeKernel((void*)fwd_kernel, dim3(grid_blocks), dim3(NTHR), args, LDS_BYTES, stream);
  if (e != hipSuccess) fprintf(stderr, "cooperative launch failed: %s (grid %d)\n", hipGetErrorString(e), grid_blocks);
#endif
}
```

```cpp
#include <hip/hip_runtime.h>
#define ONE_LAUNCH 1
#include <hip/hip_bf16.h>
#include <hip/hip_cooperative_groups.h>
#include <cstdio>
namespace cg = cooperative_groups;

typedef unsigned short u16;
using bf16x8 = __attribute__((ext_vector_type(8))) short;
using bf16x4 = __attribute__((ext_vector_type(4))) short;
using f32x4 = __attribute__((ext_vector_type(4))) float;
using f32x16 = __attribute__((ext_vector_type(16))) float;
#define DEVI __device__ __forceinline__

constexpr int NTOK = 18432, NPR = 16384, DM = 1024, ZC = 4096;
constexpr int NTHR = 256;
constexpr int LDS_BYTES = 73728;
constexpr float EPS = 1e-6f;

constexpr size_t WT_IN = 0, WT_OUT = 4194304, WT_UP = 5242880, WT_DOWN = 9437184, WT_PROJ = 13631488,
                 WT_GATE = 13893632, WT_END = 14942208;
constexpr size_t OFF_WSM = WT_END * 2;
constexpr size_t OFF_XN = OFF_WSM + 65536;
constexpr size_t OFF_Z = OFF_XN + 37748736;
constexpr size_t OFF_UTD = OFF_Z + 150994944;
constexpr size_t OFF_ATT = OFF_UTD + 18874368;
constexpr size_t OFF_ZB = OFF_ATT + 18874368;
constexpr size_t OFF_ZS = OFF_ZB + 2654208;
constexpr size_t OFF_GE = OFF_ZS + 589824;
constexpr size_t OFF_BAR = OFF_GE + 8192;
constexpr size_t OFF_WUP1 = OFF_BAR + 16384 + 32768;
constexpr size_t OFF_TB = OFF_BAR + 16384;
constexpr size_t O_RETP = 18874368, O_DNP = 19136512, O_CONVP = 19398656, O_RETS = 19417088,
                 O_DNS = 23611392, O_CONVS = 27805696;

struct Params {
  const float *x_prompt, *x_sample, *p_prompt, *p_sample, *state_ret, *state_delta, *state_conv;
  const float *norm1_g, *w_in, *conv_w, *dt_bias, *a_log, *ret_norm_g, *dn_norm_g, *w_out, *norm2_g, *w_up,
      *w_down, *ple_proj, *ple_norm_g, *ple_gate_w, *ple_gate_b, *final_norm_g;
  float* out;
  char* ws;
  int phase_lo, phase_hi, coop, pad;
};

extern __shared__ __attribute__((aligned(16))) char smem[];

typedef const __attribute__((address_space(1))) bf16x8* gptr8;
DEVI bf16x8 ldg8(const u16* p) { return *(gptr8)(p); }
DEVI int otid() {
  int t = threadIdx.x;
  asm volatile("" : "+v"(t));
  return t;
}
typedef __bf16 bf2v __attribute__((ext_vector_type(2)));
typedef float f2v __attribute__((ext_vector_type(2)));
typedef unsigned u32x2 __attribute__((ext_vector_type(2)));
DEVI unsigned pk2(float a, float b) {
  f2v v = {a, b};
  bf2v r = __builtin_convertvector(v, bf2v);
  return __builtin_bit_cast(unsigned, r);
}
DEVI u16 f2bf(float f) { return (u16)(pk2(f, 0.f) & 0xffffu); }
DEVI float bf2f(u16 h) { return __uint_as_float(((unsigned)h) << 16); }
DEVI float bfs(short h) { return __uint_as_float(((unsigned)(u16)h) << 16); }
DEVI float wave_sum(float v) {
#pragma unroll
  for (int o = 32; o > 0; o >>= 1) v += __shfl_xor(v, o);
  return v;
}
DEVI float sigmoidf_(float x) { return 1.f / (1.f + __expf(-x)); }
DEVI f32x16 mfma32(bf16x8 a, bf16x8 b, f32x16 c) { return __builtin_amdgcn_mfma_f32_32x32x16_bf16(a, b, c, 0, 0, 0); }
DEVI f32x4 mfma16(bf16x8 a, bf16x8 b, f32x4 c) { return __builtin_amdgcn_mfma_f32_16x16x32_bf16(a, b, c, 0, 0, 0); }
DEVI bf16x4 pack4(float a, float b, float c, float d) {
  u32x2 t = {pk2(a, b), pk2(c, d)};
  return __builtin_bit_cast(bf16x4, t);
}

DEVI void cvt_tile(const float* __restrict__ W, int ldn, int k0, int n0, u16* __restrict__ Wt, int ldk) {
  float* tile = (float*)smem;
  const int tid = otid();
#pragma unroll
  for (int i = 0; i < 4; i++) {
    int kk = (tid >> 4) + 16 * i, n4 = (tid & 15) * 4;
    float4 v = *(const float4*)(W + (size_t)(k0 + kk) * ldn + n0 + n4);
    tile[kk * 65 + n4] = v.x; tile[kk * 65 + n4 + 1] = v.y; tile[kk * 65 + n4 + 2] = v.z; tile[kk * 65 + n4 + 3] = v.w;
  }
  __syncthreads();
  int n = tid >> 2, ks = (tid & 3) * 16;
  bf16x8 o0, o1;
#pragma unroll
  for (int e = 0; e < 8; e++) {
    o0[e] = (short)f2bf(tile[(ks + e) * 65 + n]);
    o1[e] = (short)f2bf(tile[(ks + 8 + e) * 65 + n]);
  }
  u16* dst = Wt + (size_t)(n0 + n) * ldk + k0 + ks;
  *(bf16x8*)dst = o0;
  *(bf16x8*)(dst + 8) = o1;
  __syncthreads();
}

__device__ void convert_weights(const Params& p, int l) {
  u16* WT = (u16*)p.ws;
  const int G = gridDim.x;
  const bool early = (l == 1) && G >= 128;
  for (int t = blockIdx.x; t < 3648; t += G) {
    if (early && (t < 1024 || (t >= 1280 && t < 2304))) continue;
    if (t < 1024) {
      cvt_tile(p.w_in + (size_t)l * 1024 * 4104, 4104, (t >> 6) * 64, (t & 63) * 64, WT + WT_IN, 1024);
    } else if (t < 1280) {
      int u = t - 1024;
      cvt_tile(p.w_out + (size_t)l * 1048576, 1024, (u >> 4) * 64, (u & 15) * 64, WT + WT_OUT, 1024);
    } else if (t < 2304) {
      int u = t - 1280;
      cvt_tile(p.w_up + (size_t)l * 4194304, 4096, (u >> 6) * 64, (u & 63) * 64, WT + WT_UP, 1024);
    } else if (t < 3328) {
      int u = t - 2304;
      cvt_tile(p.w_down + (size_t)l * 4194304, 1024, (u >> 4) * 64, (u & 15) * 64, WT + WT_DOWN, 4096);
    } else if (t < 3392) {
      int u = t - 3328;
      cvt_tile(p.ple_proj + (size_t)l * 262144, 1024, (u >> 4) * 64, (u & 15) * 64, WT + WT_PROJ, 256);
    } else {
      int u = t - 3392;
      cvt_tile(p.ple_gate_w + (size_t)l * 1048576, 1024, (u >> 4) * 64, (u & 15) * 64, WT + WT_GATE, 1024);
    }
  }
  if (l == 0) {
    float2* TB = (float2*)(p.ws + OFF_TB);
    for (int i = blockIdx.x * NTHR + otid(); i < 4096; i += G * NTHR) {
      float inv = exp2f(-(float)(i & 63) * (13.287712379549449f / 64.f));
      float ang = (float)(i >> 6) * inv;
      TB[i] = make_float2(cosf(ang), sinf(ang));
    }
  }
  if (l == 0) {
    float* wsm = (float*)(p.ws + OFF_WSM);
    for (int i = blockIdx.x * NTHR + otid(); i < 16384; i += G * NTHR) {
      int ll = i >> 13, j = (i >> 10) & 7, k = i & 1023;
      wsm[i] = p.w_in[(size_t)ll * 1024 * 4104 + (size_t)k * 4104 + 4096 + j];
    }
  }
}

template <int MODE>
__device__ void norm_phase(const Params& p, int l, const float* __restrict__ gain) {
  const int tid = otid();
  const int lane = tid & 63, w = tid >> 6;
  float* H = p.out;
  u16* XN = (u16*)(p.ws + OFF_XN);
  const float* wsm = (const float*)(p.ws + OFF_WSM) + (size_t)l * 8192;
  float* ZS = (float*)(p.ws + OFF_ZS);
  for (int row = blockIdx.x * 4 + w; row < NTOK; row += gridDim.x * 4) {
    const float* src;
    if (MODE == 0) src = row < NPR ? p.x_prompt + (size_t)row * DM : p.x_sample + (size_t)(row - NPR) * DM;
    else src = H + (size_t)row * DM;
    float4 v[4];
    float ss = 0.f;
#pragma unroll
    for (int i = 0; i < 4; i++) {
      v[i] = *(const float4*)(src + i * 256 + lane * 4);
      ss += v[i].x * v[i].x + v[i].y * v[i].y + v[i].z * v[i].z + v[i].w * v[i].w;
    }
    ss = wave_sum(ss);
    float rstd = rsqrtf(ss * (1.f / 1024.f) + EPS);
    float4 y[4];
#pragma unroll
    for (int i = 0; i < 4; i++) {
      float4 g = *(const float4*)(gain + i * 256 + lane * 4);
      y[i].x = v[i].x * rstd * g.x; y[i].y = v[i].y * rstd * g.y; y[i].z = v[i].z * rstd * g.z; y[i].w = v[i].w * rstd * g.w;
    }
    if (MODE == 4) {
#pragma unroll
      for (int i = 0; i < 4; i++) *(float4*)(H + (size_t)row * DM + i * 256 + lane * 4) = y[i];
    } else {
#pragma unroll
      for (int i = 0; i < 4; i++)
        *(bf16x4*)(XN + (size_t)row * DM + i * 256 + lane * 4) = pack4(y[i].x, y[i].y, y[i].z, y[i].w);
    }
    if (MODE == 0 || MODE == 1) {
      float d[8];
#pragma unroll
      for (int j = 0; j < 8; j++) {
        float a = 0.f;
#pragma unroll
        for (int i = 0; i < 4; i++) {
          float4 wv = *(const float4*)(wsm + j * 1024 + i * 256 + lane * 4);
          a += y[i].x * wv.x + y[i].y * wv.y + y[i].z * wv.z + y[i].w * wv.w;
        }
        d[j] = wave_sum(a);
      }
      if (lane == 0) {
        *(float4*)(ZS + (size_t)row * 8) = make_float4(d[0], d[1], d[2], d[3]);
        *(float4*)(ZS + (size_t)row * 8 + 4) = make_float4(d[4], d[5], d[6], d[7]);
      }
    }
    if (MODE == 3) {
      u16* PB = (u16*)(p.ws + OFF_Z);
      const float* ps = row < NPR ? p.p_prompt + ((size_t)l * NPR + row) * 256
                                  : p.p_sample + ((size_t)l * 2048 + (row - NPR)) * 256;
      float4 pv = *(const float4*)(ps + lane * 4);
      *(bf16x4*)(PB + (size_t)row * 256 + lane * 4) = pack4(pv.x, pv.y, pv.z, pv.w);
    }
  }
}

DEVI int lds_byte(int r, int c) { return r * 128 + ((((c >> 3) ^ (r >> 1)) & 7) << 4) + (c & 7) * 2; }
DEVI void stage_rc(int b, int& R, int& C) {
  R = b >> 7;
  C = ((((b >> 4) ^ (R >> 1)) & 7) << 3);
}

DEVI void gemm_kloop(f32x4 (&acc)[4][4], const u16* __restrict__ A, int lda, const u16* __restrict__ Bt, int ldb,
                     int brow, int bcol, int K, bool pre, const u16* nA, int nlda, const u16* nBt, int nldb, int nbrow,
                     int nbcol) {
  const int tid = otid(), lane = tid & 63, wid = tid >> 6, wr = wid >> 1, wc = wid & 1, fr = lane & 15,
            fq = lane >> 4;
  const int nt = K / 64;
  int sr[4], sc[4];
#pragma unroll
  for (int i = 0; i < 4; i++) stage_rc(tid * 16 + i * 4096, sr[i], sc[i]);
  const u16* Ab = A + (size_t)brow * lda;
  const u16* Bb = Bt + (size_t)bcol * ldb;
#define GSTAGE(buf, kt)                                                                                         \
  do {                                                                                                          \
    _Pragma("unroll") for (int i = 0; i < 4; i++) {                                                             \
      int b_ = tid * 16 + i * 4096;                                                                             \
      __builtin_amdgcn_global_load_lds((const unsigned*)(Ab + (size_t)sr[i] * lda + (kt) * 64 + sc[i]),         \
                                       (unsigned*)(smem + (buf) * 32768 + b_), 16, 0, 0);                       \
      __builtin_amdgcn_global_load_lds((const unsigned*)(Bb + (size_t)sr[i] * ldb + (kt) * 64 + sc[i]),         \
                                       (unsigned*)(smem + (buf) * 32768 + 16384 + b_), 16, 0, 0);               \
    }                                                                                                           \
  } while (0)
#define GSTAGE_NEXT(buf, kt)                                                                                    \
  do {                                                                                                          \
    const u16* nAb_ = nA + (size_t)nbrow * nlda;                                                                \
    const u16* nBb_ = nBt + (size_t)nbcol * nldb;                                                               \
    _Pragma("unroll") for (int i = 0; i < 4; i++) {                                                             \
      int b_ = tid * 16 + i * 4096;                                                                             \
      __builtin_amdgcn_global_load_lds((const unsigned*)(nAb_ + (size_t)sr[i] * nlda + (kt) * 64 + sc[i]),      \
                                       (unsigned*)(smem + (buf) * 32768 + b_), 16, 0, 0);                       \
      __builtin_amdgcn_global_load_lds((const unsigned*)(nBb_ + (size_t)sr[i] * nldb + (kt) * 64 + sc[i]),      \
                                       (unsigned*)(smem + (buf) * 32768 + 16384 + b_), 16, 0, 0);               \
    }                                                                                                           \
  } while (0)
  if (!pre) { GSTAGE(0, 0); GSTAGE(1, 1); }
  for (int t = 0; t < nt; t++) {
    if (t > 0 && (t + 1 < nt || nA)) asm volatile("s_waitcnt vmcnt(8)" ::: "memory");
    else asm volatile("s_waitcnt vmcnt(0)" ::: "memory");
    __builtin_amdgcn_s_barrier();
    asm volatile("" ::: "memory");
    const char* sa = smem + (t & 1) * 32768;
    const char* sb = sa + 16384;
    bf16x8 af[4][2], bf[4][2];
#pragma unroll
    for (int m = 0; m < 4; m++)
#pragma unroll
      for (int k = 0; k < 2; k++) af[m][k] = *(const bf16x8*)(sa + lds_byte(wr * 64 + m * 16 + fr, k * 32 + fq * 8));
#pragma unroll
    for (int n = 0; n < 4; n++)
#pragma unroll
      for (int k = 0; k < 2; k++) bf[n][k] = *(const bf16x8*)(sb + lds_byte(wc * 64 + n * 16 + fr, k * 32 + fq * 8));
    asm volatile("s_waitcnt lgkmcnt(0)" ::: "memory");
    __builtin_amdgcn_s_barrier();
    asm volatile("" ::: "memory");
    if (t + 2 < nt) GSTAGE(t & 1, t + 2);
    else if (nA) GSTAGE_NEXT(t & 1, t + 2 - nt);
#pragma unroll
    for (int k = 0; k < 2; k++)
#pragma unroll
      for (int m = 0; m < 4; m++)
#pragma unroll
        for (int n = 0; n < 4; n++) acc[m][n] = mfma16(bf[n][k], af[m][k], acc[m][n]);
  }
#undef GSTAGE_NEXT
#undef GSTAGE
}

template <int EPI>
__device__ void gemm_phase(const Params& p, int l, const u16* A, int lda, const u16* Bt, int ldb, int N, int K) {
  const int tid = otid(), lane = tid & 63, wid = tid >> 6, wr = wid >> 1, wc = wid & 1, fr = lane & 15,
            fq = lane >> 4;
  const int nN = N / 128, ntile = (NTOK / 128) * nN;
  u16* Z = (u16*)(p.ws + OFF_Z);
  float* H = p.out;
  auto tile_of = [&](int t, int& tm, int& tn) -> bool {
    if (t >= ntile) return false;
    tn = t % nN; tm = t / nN;
    if (gridDim.x == 512) {
      const int k = t >> 9, x = blockIdx.x & 7, j = blockIdx.x >> 3;
      const int nsb = 18 * (nN >> 3), sb = k * 8 + x;
      if (k * 8 + 8 <= nsb) {
        const int tnb = sb % (nN >> 3), tmb = sb / (nN >> 3);
        tm = tmb * 8 + (j >> 3);
        tn = tnb * 8 + (j & 7);
      } else {
        if (j >= 16) return false;
        tm = 128 + x * 2 + (j >> 3);
        tn = j & 7;
      }
    }
    return true;
  };
  const u16* PBp = (const u16*)(p.ws + OFF_Z);
  const u16* WPp = (const u16*)p.ws + WT_PROJ;
  bool pre = false;
  for (int t = blockIdx.x; t < ntile; t += gridDim.x) {
    int tm, tn, ntm = 0, ntn = 0;
    if (!tile_of(t, tm, tn)) break;
    const bool has_next = tile_of(t + gridDim.x, ntm, ntn);
    const int brow = tm * 128, bcol = tn * 128;
    f32x4 acc[4][4];
#pragma unroll
    for (int m = 0; m < 4; m++)
#pragma unroll
      for (int n = 0; n < 4; n++) acc[m][n] = f32x4{0.f, 0.f, 0.f, 0.f};
    if (EPI != 3) {
      gemm_kloop(acc, A, lda, Bt, ldb, brow, bcol, K, pre, has_next ? A : nullptr, lda, Bt, ldb, ntm * 128, ntn * 128);
      pre = has_next;
    }
    if (EPI == 3) {
      u16* PP = (u16*)(p.ws + OFF_UTD);
      gemm_kloop(acc, PBp, 256, WPp, 256, brow, bcol, 256, pre, A, lda, Bt, ldb, brow, bcol);
#pragma unroll
      for (int m = 0; m < 4; m++)
#pragma unroll
        for (int n = 0; n < 4; n++) {
          int row = brow + wr * 64 + m * 16 + fr, col = bcol + wc * 64 + n * 16 + fq * 4;
          *(bf16x4*)(PP + (size_t)row * DM + col) = pack4(acc[m][n][0], acc[m][n][1], acc[m][n][2], acc[m][n][3]);
          acc[m][n] = f32x4{0.f, 0.f, 0.f, 0.f};
        }
      gemm_kloop(acc, A, lda, Bt, ldb, brow, bcol, K, true, has_next ? PBp : nullptr, 256, WPp, 256, ntm * 128, ntn * 128);
      pre = has_next;
#pragma unroll
      for (int m = 0; m < 4; m++)
#pragma unroll
        for (int n = 0; n < 4; n++) {
          int row = brow + wr * 64 + m * 16 + fr, col = bcol + wc * 64 + n * 16 + fq * 4;
          float4 b = *(const float4*)(p.ple_gate_b + (size_t)l * 1024 + col);
          float4* hp = (float4*)(H + (size_t)row * DM + col);
          float4 hv = *hp;
          const bf16x4 pq = *(const bf16x4*)(PP + (size_t)row * DM + col);
          hv.x += bfs(pq[0]) * sigmoidf_(acc[m][n][0] + b.x);
          hv.y += bfs(pq[1]) * sigmoidf_(acc[m][n][1] + b.y);
          hv.z += bfs(pq[2]) * sigmoidf_(acc[m][n][2] + b.z);
          hv.w += bfs(pq[3]) * sigmoidf_(acc[m][n][3] + b.w);
          *hp = hv;
        }
    } else {
#pragma unroll
      for (int m = 0; m < 4; m++)
#pragma unroll
        for (int n = 0; n < 4; n++) {
          int row = brow + wr * 64 + m * 16 + fr, col = bcol + wc * 64 + n * 16 + fq * 4;
          f32x4 a = acc[m][n];
          if (EPI == 0) {
            bf16x4 zb4 = pack4(a[0], a[1], a[2], a[3]);
            *(bf16x4*)(Z + (size_t)row * ZC + col) = zb4;
            int rr = (row & 63) - 61;
            if (rr >= 0 && col >= 2048 && col < 3584) {
              u16* ZB = (u16*)(p.ws + OFF_ZB);
              int ch = col - 2048;
              *(bf16x4*)(ZB + ((size_t)(row >> 6) * 3 + rr) * 1536 + ch) = zb4;
              if (row >= NPR) {
                int b = (row - NPR) >> 6;
                *(float4*)(p.out + O_CONVS + (((size_t)l * 32 + b) * 3 + rr) * 1536 + ch) = make_float4(a[0], a[1], a[2], a[3]);
              } else if ((row & 8191) >= 8189) {
                int b = row >> 13;
                *(float4*)(p.out + O_CONVP + (((size_t)l * 2 + b) * 3 + rr) * 1536 + ch) = make_float4(a[0], a[1], a[2], a[3]);
              }
            }
          } else if (EPI == 1) {
            float4* hp = (float4*)(H + (size_t)row * DM + col);
            const float* rs = (l == 0 && K == 1024)
                                  ? (row < NPR ? p.x_prompt + (size_t)row * DM + col : p.x_sample + (size_t)(row - NPR) * DM + col)
                                  : (const float*)hp;
            float4 hv = *(const float4*)rs;
            hv.x += a[0]; hv.y += a[1]; hv.z += a[2]; hv.w += a[3];
            *hp = hv;
          } else if (EPI == 2) {
            float r0 = fmaxf(a[0], 0.f), r1 = fmaxf(a[1], 0.f), r2 = fmaxf(a[2], 0.f), r3 = fmaxf(a[3], 0.f);
            *(bf16x4*)(Z + (size_t)row * ZC + col) = pack4(r0 * r0, r1 * r1, r2 * r2, r3 * r3);
          }
        }
    }
  }
}


template <int KS>
DEVI int fragA(int row, int k8) { return ((((row >> 5) * KS + (k8 >> 1)) * 2 + (k8 & 1)) * 32 + (row & 31)) * 8; }
DEVI int fragU(int dv, int tok) {
  return ((((dv >> 5) * 2 + (tok >> 5)) * 64 + ((tok >> 2) & 1) * 32 + (dv & 31)) * 16) + ((tok >> 3) & 3) * 4;
}
DEVI size_t slotaddr(int row0, int slot, int L) { return (size_t)(row0 + (L >> 7)) * ZC + slot + (L & 127); }

constexpr int LP = 136;

__device__ void c2_ret(const Params& p, int l, int chunk, int h) {
  u16* Z = (u16*)(p.ws + OFF_Z);
  u16* ATT = (u16*)(p.ws + OFF_ATT);
  int tid_ = threadIdx.x;
  asm volatile("" : "+v"(tid_));
  const int tid = tid_, lane = tid & 63, w = __builtin_amdgcn_readfirstlane(tid >> 6), r = lane & 31, hh = lane >> 5;
  u16* qs = (u16*)smem;
  u16* ks = qs + 64 * LP;
  u16* vs = ks + 64 * LP;
  const int row0 = chunk * 64;
  const bool is_sample = chunk >= 256;
  const int pos0 = is_sample ? 4096 : (chunk & 127) * 64;
  const float lg2 = log2f(1.f - exp2f(-5.f - (float)h));
  const int cq = h * 128, ck = 512 + h * 128, cv = 1024 + h * 128;
  {
    const float2* TB = (const float2*)(p.ws + OFF_TB);
    float2* ab = (float2*)(smem + 52224);
    bf16x8 q1[2], q2[2], k1[2], k2[2], vv[4];
#pragma unroll
    for (int it = 0; it < 2; it++) {
      int item = it * 256 + tid;
      int t = item >> 3, cg8 = (item & 7) * 8;
      size_t zr = (size_t)(row0 + t) * ZC;
      q1[it] = *(const bf16x8*)(Z + zr + cq + cg8); q2[it] = *(const bf16x8*)(Z + zr + cq + 64 + cg8);
      k1[it] = *(const bf16x8*)(Z + zr + ck + cg8); k2[it] = *(const bf16x8*)(Z + zr + ck + 64 + cg8);
    }
#pragma unroll
    for (int it = 0; it < 4; it++) {
      int item = it * 256 + tid;
      vv[it] = *(const bf16x8*)(Z + (size_t)(row0 + (item >> 4)) * ZC + cv + (item & 15) * 8);
    }
    if (tid < 64) {
      float inv = exp2f(-(float)tid * (13.287712379549449f / 64.f));
      float ang = (float)pos0 * inv;
      ab[tid] = make_float2(cosf(ang), sinf(ang));
    }
#pragma unroll
    for (int it = 0; it < 4; it++) {
      int item = it * 256 + tid;
      *(bf16x8*)(vs + (item >> 4) * LP + (item & 15) * 8) = vv[it];
    }
    __syncthreads();
#pragma unroll
    for (int it = 0; it < 2; it++) {
      int item = it * 256 + tid;
      int t = item >> 3, cg8 = (item & 7) * 8;
      bf16x8 sq1, sq2, sk1, sk2;
#pragma unroll
      for (int e = 0; e < 8; e++) {
        int d = cg8 + e;
        float2 B = TB[t * 64 + d], A = ab[d];
        float cs = A.x * B.x - A.y * B.y, sn = A.y * B.x + A.x * B.y;
        float a = bfs(q1[it][e]), b = bfs(q2[it][e]);
        float qa = a * cs - b * sn, qb = a * sn + b * cs;
        sq1[e] = (short)f2bf(qa); sq2[e] = (short)f2bf(qb);
        a = bfs(k1[it][e]); b = bfs(k2[it][e]);
        float ka = (a * cs - b * sn) * 0.08838834764831845f, kb = (a * sn + b * cs) * 0.08838834764831845f;
        sk1[e] = (short)f2bf(ka); sk2[e] = (short)f2bf(kb);
      }
      *(bf16x8*)(qs + t * LP + cg8) = sq1; *(bf16x8*)(qs + t * LP + 64 + cg8) = sq2;
      *(bf16x8*)(ks + t * LP + cg8) = sk1; *(bf16x8*)(ks + t * LP + 64 + cg8) = sk2;
    }
  }
  __syncthreads();
  {
    const int ib = w & 1, jb = w >> 1;
    f32x16 acc;
#pragma unroll
    for (int e = 0; e < 16; e++) acc[e] = 0.f;
#pragma unroll
    for (int kk = 0; kk < 8; kk++) {
      bf16x8 a = *(const bf16x8*)(ks + (jb * 32 + r) * LP + kk * 16 + hh * 8);
      bf16x8 b = *(const bf16x8*)(qs + (ib * 32 + r) * LP + kk * 16 + hh * 8);
      acc = mfma32(a, b, acc);
    }
    const int i = ib * 32 + r;
    u16* att = ATT + (size_t)(chunk * 4 + h) * 4096;
#pragma unroll
    for (int g = 0; g < 4; g++) {
      int j0 = jb * 32 + 8 * g + 4 * hh;
      float o[4];
#pragma unroll
      for (int e = 0; e < 4; e++) {
        int dj = i - (j0 + e);
        dj = dj < 0 ? -dj : dj;
        o[e] = acc[4 * g + e] * exp2f(lg2 * (float)dj);
      }
      *(bf16x4*)(att + fragA<4>(i, j0 >> 3) + (j0 & 7)) = pack4(o[0], o[1], o[2], o[3]);
    }
  }
#pragma unroll 1
  for (int it = 0; it < 4; it++) {
    int item = it * 256 + tid;
    int t = item >> 4, c16 = item & 15;
    bf16x8 v = *(const bf16x8*)(qs + t * LP + c16 * 8);
    float cross = exp2f(lg2 * (float)(t + 1));
    bf16x8 o;
#pragma unroll
    for (int e = 0; e < 8; e++) o[e] = (short)f2bf(bfs(v[e]) * cross);
    *(bf16x8*)(Z + slotaddr(row0, cq, fragA<8>(t, c16))) = o;
  }
  {
    const int d = tid & 127, half = tid >> 7;
#pragma unroll
    for (int q4 = 0; q4 < 4; q4++) {
      bf16x8 ok;
      bf16x4 ov0, ov1;
      const int t8 = half * 32 + q4 * 8;
#pragma unroll
      for (int e = 0; e < 8; e++) {
        int tt = t8 + e;
        ok[e] = (short)f2bf(bf2f(ks[tt * LP + d]) * exp2f(lg2 * (float)(63 - tt)));
        if (e < 4) ov0[e & 3] = (short)vs[tt * LP + d]; else ov1[e & 3] = (short)vs[tt * LP + d];
      }
      *(bf16x8*)(Z + slotaddr(row0, ck, fragA<4>(d, t8 >> 3))) = ok;
      *(bf16x4*)(Z + slotaddr(row0, cv, fragU(d, t8))) = ov0;
      *(bf16x4*)(Z + slotaddr(row0, cv, fragU(d, t8 + 4))) = ov1;
    }
  }
  __syncthreads();
}

__device__ void c2_delta(const Params& p, int l, int chunk, int h) {
  u16* Z = (u16*)(p.ws + OFF_Z);
  u16* ATT = (u16*)(p.ws + OFF_ATT);
  u16* UTD = (u16*)(p.ws + OFF_UTD);
  const u16* ZB = (const u16*)(p.ws + OFF_ZB);
  const float* ZS = (const float*)(p.ws + OFF_ZS);
  float* GE = (float*)(p.ws + OFF_GE);
  int tid_ = threadIdx.x;
  asm volatile("" : "+v"(tid_));
  const int tid = tid_, lane = tid & 63, w = __builtin_amdgcn_readfirstlane(tid >> 6), r = lane & 31, hh = lane >> 5;
  u16* qs = (u16*)smem;
  u16* ks = qs + 64 * LP;
  u16* vs = ks + 64 * LP;
  float* Af = (float*)(vs + 64 * LP);
  float* gcs = Af + 4096;
  float* su = gcs + 64;
  float* sw = su + 64;
  float* egq = sw + 64;
  float* egk = egq + 64;
  const int row0 = chunk * 64;
  const bool is_sample = chunk >= 256;
  const int nseq = is_sample ? 0 : (chunk & 127);
  const int sb = chunk - 256;
  if (w < 3) {
    const int part = w, tb = lane >> 4, cg8 = (lane & 15) * 8;
    const int ch = part * 512 + h * 128 + cg8;
    bf16x8 xr[19];
#pragma unroll
    for (int j = 0; j < 19; j++) {
      int tt = tb * 16 - 3 + j;
      tt = tt < 0 ? 0 : tt;
      xr[j] = *(const bf16x8*)(Z + (size_t)(row0 + tt) * ZC + 2048 + ch);
    }
    float4 cw0[4], cw1[4];
#pragma unroll
    for (int i = 0; i < 4; i++) {
      const float* cw = p.conv_w + ((size_t)l * 4 + i) * 1536 + ch;
      cw0[i] = *(const float4*)cw;
      cw1[i] = *(const float4*)(cw + 4);
    }
    if (tb == 0) {
#pragma unroll
      for (int j = 0; j < 3; j++) {
        if (is_sample) {
          const float* s = p.state_conv + (((size_t)l * 32 + sb) * 3 + j) * 1536 + ch;
          float4 s0 = *(const float4*)s, s1 = *(const float4*)(s + 4);
          u32x2 lo = {pk2(s0.x, s0.y), pk2(s0.z, s0.w)}, hi = {pk2(s1.x, s1.y), pk2(s1.z, s1.w)};
          bf16x4 l4 = __builtin_bit_cast(bf16x4, lo), h4 = __builtin_bit_cast(bf16x4, hi);
          xr[j] = bf16x8{l4[0], l4[1], l4[2], l4[3], h4[0], h4[1], h4[2], h4[3]};
        } else if (nseq > 0) {
          xr[j] = *(const bf16x8*)(ZB + ((size_t)(chunk - 1) * 3 + j) * 1536 + ch);
        } else {
          xr[j] = bf16x8{0, 0, 0, 0, 0, 0, 0, 0};
        }
      }
    }
    u16* dst = part == 0 ? qs : (part == 1 ? ks : vs);
#pragma unroll
    for (int i = 0; i < 16; i++) {
      float a[8];
#pragma unroll
      for (int e = 0; e < 8; e++) a[e] = 0.f;
#pragma unroll
      for (int tp = 0; tp < 4; tp++) {
        const bf16x8 v = xr[i + tp];
        a[0] += bfs(v[0]) * cw0[tp].x; a[1] += bfs(v[1]) * cw0[tp].y; a[2] += bfs(v[2]) * cw0[tp].z; a[3] += bfs(v[3]) * cw0[tp].w;
        a[4] += bfs(v[4]) * cw1[tp].x; a[5] += bfs(v[5]) * cw1[tp].y; a[6] += bfs(v[6]) * cw1[tp].z; a[7] += bfs(v[7]) * cw1[tp].w;
      }
      float ss = 0.f;
#pragma unroll
      for (int e = 0; e < 8; e++) {
        a[e] = a[e] * sigmoidf_(a[e]);
        ss += a[e] * a[e];
      }
      if (part < 2) {
        ss += __shfl_xor(ss, 1); ss += __shfl_xor(ss, 2); ss += __shfl_xor(ss, 4); ss += __shfl_xor(ss, 8);
        float sc = rsqrtf(ss + EPS) * (part == 0 ? 0.08838834764831845f : 1.f);
#pragma unroll
        for (int e = 0; e < 8; e++) a[e] *= sc;
      }
      u32x2 lo = {pk2(a[0], a[1]), pk2(a[2], a[3])}, hi = {pk2(a[4], a[5]), pk2(a[6], a[7])};
      *(u32x2*)(dst + (tb * 16 + i) * LP + cg8) = lo;
      *(u32x2*)(dst + (tb * 16 + i) * LP + cg8 + 4) = hi;
    }
  }
  if (w == 3) {
    const int row = row0 + lane;
    float bb = ZS[(size_t)row * 8 + h], ab = ZS[(size_t)row * 8 + 4 + h];
    float beta = sigmoidf_(bb);
    float x = ab + p.dt_bias[l * 4 + h];
    float sp = x > 20.f ? x : log1pf(expf(x));
    float gc = -expf(p.a_log[l * 4 + h]) * sp;
#pragma unroll
    for (int o = 1; o < 64; o <<= 1) {
      float v = __shfl_up(gc, o);
      if (lane >= o) gc += v;
    }
    float gl = __shfl(gc, 63);
    gcs[lane] = gc;
    su[lane] = beta;
    sw[lane] = beta * expf(gc);
    egq[lane] = expf(gc);
    egk[lane] = expf(gl - gc);
    if (lane == 63) GE[chunk * 4 + h] = expf(gc);
  }
  __syncthreads();
  {
    const int ib = w & 1, jb = w >> 1;
    const int i = ib * 32 + r;
    u16* att = ATT + (size_t)(1152 + chunk * 4 + h) * 4096;
    if (jb <= ib) {
      f32x16 aK, aQ;
#pragma unroll
      for (int e = 0; e < 16; e++) { aK[e] = 0.f; aQ[e] = 0.f; }
#pragma unroll
      for (int kk = 0; kk < 8; kk++) {
        bf16x8 a = *(const bf16x8*)(ks + (jb * 32 + r) * LP + kk * 16 + hh * 8);
        bf16x8 bk = *(const bf16x8*)(ks + (ib * 32 + r) * LP + kk * 16 + hh * 8);
        bf16x8 bq = *(const bf16x8*)(qs + (ib * 32 + r) * LP + kk * 16 + hh * 8);
        aK = mfma32(a, bk, aK);
        aQ = mfma32(a, bq, aQ);
      }
      const float gi = gcs[i], bi = su[i];
#pragma unroll
      for (int g = 0; g < 4; g++) {
        int j0 = jb * 32 + 8 * g + 4 * hh;
        float oa[4], oq[4];
#pragma unroll
        for (int e = 0; e < 4; e++) {
          int j = j0 + e;
          float dec = (i >= j) ? expf(gi - gcs[j]) : 0.f;
          oa[e] = (i > j) ? aK[4 * g + e] * bi * dec : 0.f;
          oq[e] = aQ[4 * g + e] * dec;
        }
        *(float4*)(Af + i * 64 + j0) = make_float4(oa[0], oa[1], oa[2], oa[3]);
        *(bf16x4*)(att + fragA<4>(i, j0 >> 3) + (j0 & 7)) = pack4(oq[0], oq[1], oq[2], oq[3]);
      }
    } else {
#pragma unroll
      for (int g = 0; g < 4; g++) {
        int j0 = jb * 32 + 8 * g + 4 * hh;
        *(float4*)(Af + i * 64 + j0) = make_float4(0.f, 0.f, 0.f, 0.f);
        *(bf16x4*)(att + fragA<4>(i, j0 >> 3) + (j0 & 7)) = bf16x4{0, 0, 0, 0};
      }
    }
  }
  __syncthreads();
  {
#pragma unroll 1
    for (int it = 0; it < 4; it++) {
      int item = it * 256 + tid;
      int t = item >> 4, c8 = (item & 15) * 8;
      bf16x8 v = *(const bf16x8*)(qs + t * LP + c8);
      float sc = egq[t];
      bf16x8 o;
#pragma unroll
      for (int e = 0; e < 8; e++) o[e] = (short)f2bf(bfs(v[e]) * sc);
      *(bf16x8*)(Z + slotaddr(row0, 2560 + h * 128, fragA<8>(t, c8 >> 3))) = o;
    }
    const int d = tid & 127, half = tid >> 7;
#pragma unroll
    for (int q4 = 0; q4 < 4; q4++) {
      bf16x8 ok;
#pragma unroll
      for (int e = 0; e < 8; e++) {
        int tt = half * 32 + q4 * 8 + e;
        ok[e] = (short)f2bf(bf2f(ks[tt * LP + d]) * egk[tt]);
      }
      *(bf16x8*)(Z + slotaddr(row0, 3072 + h * 128, fragA<4>(d, (half * 32 + q4 * 8) >> 3))) = ok;
    }
  }
  __syncthreads();
  {
    const int cc = tid & 127;
    const u16* src = (tid < 128) ? vs : ks;
    const float* scl = (tid < 128) ? su : sw;
    float x[64];
    int vzero;
    asm volatile("v_mov_b32 %0, 0" : "=v"(vzero));
    const float* Afv = Af + vzero;
    const float* sclv = scl + vzero;
#pragma unroll
    for (int i = 0; i < 64; i++) {
      float acc = bf2f(src[i * LP + cc]) * sclv[i], acc2 = 0.f;
#pragma unroll
      for (int j4 = 0; j4 < (i + 3) / 4; j4++) {
        float4 av = *(const float4*)(Afv + i * 64 + j4 * 4);
        if (j4 * 4 + 0 < i) acc -= av.x * x[j4 * 4 + 0];
        if (j4 * 4 + 1 < i) acc2 -= av.y * x[j4 * 4 + 1];
        if (j4 * 4 + 2 < i) acc -= av.z * x[j4 * 4 + 2];
        if (j4 * 4 + 3 < i) acc2 -= av.w * x[j4 * 4 + 3];
      }
      x[i] = acc + acc2;
      __builtin_amdgcn_sched_barrier(0);
    }
    if (tid < 128) {
      u16* ut = UTD + (size_t)(chunk * 4 + h) * 8192;
#pragma unroll
      for (int q4 = 0; q4 < 16; q4++)
        *(bf16x4*)(ut + fragU(cc, q4 * 4)) = pack4(x[q4 * 4], x[q4 * 4 + 1], x[q4 * 4 + 2], x[q4 * 4 + 3]);
    } else {
#pragma unroll
      for (int i = 0; i < 64; i++) qs[i * LP + cc] = f2bf(x[i]);
    }
  }
  __syncthreads();
#pragma unroll 1
  for (int it = 0; it < 4; it++) {
    int item = it * 256 + tid;
    int t = item >> 4, c8 = (item & 15) * 8;
    *(bf16x8*)(Z + slotaddr(row0, 2048 + h * 128, fragA<8>(t, c8 >> 3))) = *(const bf16x8*)(qs + t * LP + c8);
  }
  __syncthreads();
}

constexpr int STP = 136, VNP = 72, OBP = 40;
__device__ void scan_task(const Params& p, int l, int type, int seq, int h, int s) {
  const u16* Z = (const u16*)(p.ws + OFF_Z);
  const u16* ATT = (const u16*)(p.ws + OFF_ATT);
  const u16* UTD = (const u16*)(p.ws + OFF_UTD);
  const float* GE = (const float*)(p.ws + OFF_GE);
  u16* XN = (u16*)(p.ws + OFF_XN);
  const int tid = otid(), lane = tid & 63, w = __builtin_amdgcn_readfirstlane(tid >> 6), r = lane & 31, hh = lane >> 5;
  u16* ST = (u16*)smem;
  u16* VNT = ST + 32 * STP;
  u16* OB = VNT + 32 * VNP;
  const int nchunks = seq < 2 ? 128 : 1;
  const int chunk0 = seq < 2 ? seq * 128 : 256 + (seq - 2);
  const int dv0 = s * 32;
  const int c0 = type ? 2048 + h * 128 : h * 128;
  const int c1 = c0 + 512, c2 = c0 + 1024;
  const int colA8 = (w < 2) ? c0 : (type ? c1 : c0);
  const int colKT = type ? c2 : c1;
  const int mb = w & 1;
  const float carry = exp2f(64.f * log2f(1.f - exp2f(-5.f - (float)h)));
  f32x16 S;
  if (seq < 2) {
#pragma unroll
    for (int e = 0; e < 16; e++) S[e] = 0.f;
  } else {
    const float* s0 = (type ? p.state_delta : p.state_ret) + (((size_t)l * 32 + (seq - 2)) * 4 + h) * 16384;
#pragma unroll
    for (int e = 0; e < 16; e++) {
      int dk = w * 32 + (e & 3) + 8 * (e >> 2) + 4 * hh;
      S[e] = s0[(size_t)dk * 128 + dv0 + r];
    }
  }
#pragma unroll
  for (int g = 0; g < 4; g++)
    *(bf16x4*)(ST + r * STP + w * 32 + 8 * g + 4 * hh) = pack4(S[4 * g], S[4 * g + 1], S[4 * g + 2], S[4 * g + 3]);

  struct Ops { bf16x8 F8[8]; bf16x8 F4[4]; bf16x8 KT[4]; };
  const bool needA8 = (w >= 2) || type;
  auto load_ops = [&](Ops& o, int chunk) {
    const u16* zb = Z + (size_t)(chunk * 64 + (lane >> 4)) * ZC + (lane & 15) * 8;
    asm volatile("" : "+v"(zb));
    {
      const u16* a8 = zb + (size_t)(mb * 32) * ZC + colA8;
#pragma unroll
      for (int ks = 0; ks < 8; ks++) o.F8[ks] = ldg8(a8 + (size_t)(ks * 4) * ZC);
    }
    {
      const u16* f4p;
      int f4s;
      if (w >= 2) {
        f4p = ATT + (size_t)(type * 1152 + chunk * 4 + h) * 4096 + (mb * 256 + lane) * 8;
        f4s = 512;
      } else {
        const int L_ = ((s * 2 + mb) * 64 + lane) * 16;
        f4p = type ? UTD + (size_t)(chunk * 4 + h) * 8192 + L_ : Z + slotaddr(chunk * 64, c2, L_);
        f4s = 8;
      }
#pragma unroll
      for (int ks = 0; ks < 4; ks++) o.F4[ks] = ldg8(f4p + ((w >= 2) ? ks : (ks & 1)) * f4s);
    }
    {
      const u16* kt = zb + (size_t)(w * 16) * ZC + colKT;
#pragma unroll
      for (int ks = 0; ks < 4; ks++) o.KT[ks] = ldg8(kt + (size_t)(ks * 4) * ZC);
    }
  };
#define LBAR() do { asm volatile("s_waitcnt lgkmcnt(0)" ::: "memory"); __builtin_amdgcn_s_barrier(); asm volatile("" ::: "memory"); } while (0)
  auto step = [&](const Ops& o, int chunk, float ge) {
    f32x16 acc;
#pragma unroll
    for (int e = 0; e < 16; e++) acc[e] = 0.f;
    if (needA8) {
      f32x16 acc2;
#pragma unroll
      for (int e = 0; e < 16; e++) acc2[e] = 0.f;
      bf16x8 sb[8];
#pragma unroll
      for (int ks = 0; ks < 8; ks++) sb[ks] = *(const bf16x8*)(ST + r * STP + ks * 16 + hh * 8);
#pragma unroll
      for (int ks = 0; ks < 8; ks += 2) {
        acc = mfma32(o.F8[ks], sb[ks], acc);
        acc2 = mfma32(o.F8[ks + 1], sb[ks + 1], acc2);
      }
#pragma unroll
      for (int e = 0; e < 16; e++) acc[e] += acc2[e];
    }
    if (w < 2) {
#pragma unroll
      for (int g = 0; g < 4; g++) {
        const bf16x8 uu = o.F4[g >> 1];
        const int ub = (g & 1) * 4;
        float v0 = bfs(uu[ub]) - acc[4 * g], v1 = bfs(uu[ub + 1]) - acc[4 * g + 1], v2 = bfs(uu[ub + 2]) - acc[4 * g + 2],
              v3 = bfs(uu[ub + 3]) - acc[4 * g + 3];
        *(bf16x4*)(VNT + r * VNP + mb * 32 + 8 * g + 4 * hh) = pack4(v0, v1, v2, v3);
      }
    }
    LBAR();
    bf16x8 vb[4];
#pragma unroll
    for (int ks = 0; ks < 4; ks++) vb[ks] = *(const bf16x8*)(VNT + r * VNP + ks * 16 + hh * 8);
#pragma unroll
    for (int e = 0; e < 16; e++) S[e] *= ge;
#pragma unroll
    for (int ks = 0; ks < 4; ks++) S = mfma32(o.KT[ks], vb[ks], S);
#pragma unroll
    for (int g = 0; g < 4; g++)
      *(bf16x4*)(ST + r * STP + w * 32 + 8 * g + 4 * hh) = pack4(S[4 * g], S[4 * g + 1], S[4 * g + 2], S[4 * g + 3]);
    if (w >= 2) {
#pragma unroll
      for (int ks = 0; ks < 4; ks++) acc = mfma32(o.F4[ks], vb[ks], acc);
      u16* op = XN + (size_t)(chunk * 64 + mb * 32) * DM + type * 512 + h * 128 + dv0 + r;
#pragma unroll
      for (int e = 0; e < 16; e++) {
        const int tok = (e & 3) + 8 * (e >> 2) + 4 * hh;
        const unsigned val = f2bf(acc[e]);
        asm volatile("global_store_short %0, %1, off" ::"v"(op + (size_t)tok * DM), "v"(val) : "memory");
      }
    }
    LBAR();
  };
  float gev0 = carry, gev1 = carry;
  if (type) {
    gev0 = (lane < nchunks) ? GE[(chunk0 + lane) * 4 + h] : 1.f;
    gev1 = (64 + lane < nchunks) ? GE[(chunk0 + 64 + lane) * 4 + h] : 1.f;
  }
  auto flush = [&](int cbase, int nst) {
    for (int it = tid; it < nst * 256; it += 256) {
      int st = it >> 8, tok = (it >> 2) & 63, pc = it & 3;
      bf16x8 v = *(const bf16x8*)(OB + (((cbase + st) & 7) * 64 + tok) * OBP + pc * 8);
      *(bf16x8*)(XN + (size_t)((cbase + st) * 64 + tok) * DM + type * 512 + h * 128 + dv0 + pc * 8) = v;
    }
    __builtin_amdgcn_s_waitcnt(0x0F70);
  };
  Ops A, B;
  load_ops(A, chunk0);
  __syncthreads();
#define GEV(n_) __uint_as_float(__builtin_amdgcn_readlane(__float_as_uint((n_) < 64 ? gev0 : gev1), (n_) & 63))
  int n = 0;
#pragma unroll 1
  for (; n + 2 < nchunks; n += 2) {
    load_ops(B, chunk0 + n + 1);
    step(A, chunk0 + n, GEV(n));
    load_ops(A, chunk0 + n + 2);
    step(B, chunk0 + n + 1, GEV(n + 1));
  }
  if (n + 1 < nchunks) {
    load_ops(B, chunk0 + n + 1);
    step(A, chunk0 + n, GEV(n));
    step(B, chunk0 + n + 1, GEV(n + 1));
  } else {
    step(A, chunk0 + n, GEV(n));
  }
#undef GEV
#undef LBAR
  float* so;
  if (seq < 2) so = p.out + (type ? O_DNP : O_RETP) + (((size_t)l * 2 + seq) * 4 + h) * 16384;
  else so = p.out + (type ? O_DNS : O_RETS) + (((size_t)l * 32 + (seq - 2)) * 4 + h) * 16384;
#pragma unroll
  for (int e = 0; e < 16; e++) {
    int dk = w * 32 + (e & 3) + 8 * (e >> 2) + 4 * hh;
    so[(size_t)dk * 128 + dv0 + r] = S[e];
  }
  __syncthreads();
}

__device__ void scan_phase(const Params& p, int l) {
  const int G = gridDim.x, b = blockIdx.x;
  if (G >= 128) {
    if (b < 64) {
      int type = (b < 32) ? 1 : 0;
      int bh = b & 7, s = (b >> 3) & 3;
      scan_task(p, l, type, bh >> 2, bh & 3, s);
    } else {
      for (int u = b - 64; u < 1024; u += G - 64) {
        int type = u & 1, s = (u >> 1) & 3, h = (u >> 3) & 3, bb = u >> 5;
        scan_task(p, l, type, 2 + bb, h, s);
      }
      if (l == 0) {
        u16* WT = (u16*)p.ws;
        for (int t = b - 64; t < 2048; t += G - 64) {
          if (t < 1024) {
            cvt_tile(p.w_in + (size_t)1024 * 4104, 4104, (t >> 6) * 64, (t & 63) * 64, WT + WT_IN, 1024);
          } else {
            int u = t - 1024;
            cvt_tile(p.w_up + (size_t)4194304, 4096, (u >> 6) * 64, (u & 63) * 64, (u16*)(p.ws + OFF_WUP1), 1024);
          }
        }
      }
    }
  } else {
    for (int t = b; t < 1088; t += G) {
      if (t < 64) {
        int type = (t < 32) ? 1 : 0;
        int bh = t & 7, s = (t >> 3) & 3;
        scan_task(p, l, type, bh >> 2, bh & 3, s);
      } else {
        int u = t - 64;
        int type = u & 1, s = (u >> 1) & 3, h = (u >> 3) & 3, bb = u >> 5;
        scan_task(p, l, type, 2 + bb, h, s);
      }
    }
  }
}

__device__ void fin_phase(const Params& p, int l) {
  const int tid = otid();
  const int lane = tid & 63, w = tid >> 6;
  u16* XN = (u16*)(p.ws + OFF_XN);
  const u16* Z = (const u16*)(p.ws + OFF_Z);
  for (int row = blockIdx.x * 4 + w; row < NTOK; row += gridDim.x * 4) {
    u16* op = XN + (size_t)row * DM + lane * 16;
    bf16x8 o0 = *(const bf16x8*)op, o1 = *(const bf16x8*)(op + 8);
    float v[16];
#pragma unroll
    for (int e = 0; e < 8; e++) { v[e] = bfs(o0[e]); v[8 + e] = bfs(o1[e]); }
    const bool ret = lane < 32;
    float s1 = 0.f, s2 = 0.f;
#pragma unroll
    for (int e = 0; e < 16; e++) { s1 += v[e]; s2 += v[e] * v[e]; }
    s1 += __shfl_xor(s1, 1); s1 += __shfl_xor(s1, 2); s1 += __shfl_xor(s1, 4);
    s2 += __shfl_xor(s2, 1); s2 += __shfl_xor(s2, 2); s2 += __shfl_xor(s2, 4);
    float mu = ret ? s1 * (1.f / 128.f) : 0.f;
    float var = s2 * (1.f / 128.f) - mu * mu;
    var = fmaxf(var, 0.f);
    float rstd = rsqrtf(var + EPS);
    const int col = lane * 16;
    const u16* gp = Z + (size_t)row * ZC + (ret ? 1536 + col : 3584 + (col - 512));
    bf16x8 g0 = *(const bf16x8*)gp, g1 = *(const bf16x8*)(gp + 8);
    const float* ng = ret ? p.ret_norm_g + (size_t)l * 512 + col : p.dn_norm_g + (size_t)l * 128 + (col & 127);
    bf16x8 r0, r1;
#pragma unroll
    for (int e = 0; e < 16; e++) {
      float gt = bfs(e < 8 ? g0[e & 7] : g1[e & 7]);
      float y = (v[e] - mu) * rstd * ng[e] * (gt * sigmoidf_(gt));
      if (e < 8) r0[e & 7] = (short)f2bf(y); else r1[e & 7] = (short)f2bf(y);
    }
    *(bf16x8*)op = r0;
    *(bf16x8*)(op + 8) = r1;
  }
}


#define XB_TMO      128
#define XB_XCNT(j)  (256  + 64 * (j))
#define XB_XSUB(j)  (1280 + 64 * (j))
#define XB_XGEN(j)  (2304 + 64 * (j))
#define XB_TOP      3328
#define XB_TOPGEN   3392
#define XCD_BAR_WORDS 3456
#define XB_SPIN_CAP (1u << 22)
#define LAS __attribute__((address_space(3)))
DEVI unsigned xb_ld(unsigned* p) { return __hip_atomic_load(p, __ATOMIC_RELAXED, __HIP_MEMORY_SCOPE_AGENT); }
DEVI unsigned xb_add(unsigned* p, unsigned v) { return __hip_atomic_fetch_add(p, v, __ATOMIC_RELAXED, __HIP_MEMORY_SCOPE_AGENT); }
DEVI unsigned xb_xcc_id() { return (unsigned)__builtin_amdgcn_s_getreg((3 << 11) | 20) & 0xFu; }
#define XB_SPIN(cond, bar) do { unsigned _sp = 0; while (cond) { __builtin_amdgcn_s_sleep(1); \
    if ((++_sp & 255u) == 0u) { if (xb_ld(&(bar)[XB_TMO])) break; if (_sp > XB_SPIN_CAP) { atomicAdd(&(bar)[XB_TMO], 1u); break; } } } } while (0)
struct XcdBarrier { unsigned* bar; unsigned x; volatile LAS unsigned* st; };
DEVI XcdBarrier xcd_barrier_post(unsigned* bar, volatile LAS unsigned* st) {
  XcdBarrier b; b.bar = bar; b.x = xb_xcc_id(); b.st = st;
  if (threadIdx.x == 0) (void)xb_add(&bar[XB_XCNT(b.x)], 1u);
  return b;
}
DEVI void xcd_barrier_complete(unsigned* bar, unsigned x, unsigned& nloc, unsigned& nx) {
  const unsigned G = gridDim.x * gridDim.y * gridDim.z;
  unsigned sum, cnt, mine, sp = 0u;
  for (;;) {
    sum = 0u; cnt = 0u; mine = 0u;
#pragma unroll
    for (unsigned j = 0; j < 16; ++j) { const unsigned c = xb_ld(&bar[XB_XCNT(j)]); sum += c; cnt += (c > 0u) ? 1u : 0u; mine = (j == x) ? c : mine; }
    if (sum == G) break;
    __builtin_amdgcn_s_sleep(1);
    if ((++sp & 255u) == 0u) { if (xb_ld(&bar[XB_TMO])) break; if (sp > XB_SPIN_CAP) { atomicAdd(&bar[XB_TMO], 1u); break; } }
  }
  nloc = mine > 0u ? mine : 1u; nx = cnt > 0u ? cnt : 1u;
}
DEVI void xcd_barrier(const XcdBarrier& b) {
  asm volatile("s_waitcnt vmcnt(0)" ::: "memory");
  __syncthreads();
  if (threadIdx.x == 0) {
    unsigned* bar = b.bar;
    __builtin_amdgcn_s_waitcnt(0);
    unsigned nloc = b.st[0], nx = b.st[1];
    if (nloc == 0u) { xcd_barrier_complete(bar, b.x, nloc, nx); b.st[0] = nloc; b.st[1] = nx; }
    const unsigned old = xb_add(&bar[XB_XSUB(b.x)], 1u);
    const unsigned gen = old / nloc;
    if (old + 1u == (gen + 1u) * nloc) {
      __builtin_amdgcn_fence(__ATOMIC_RELEASE, "agent");
      asm volatile("s_waitcnt vmcnt(0)" ::: "memory");
      const unsigned og = xb_add(&bar[XB_TOP], 1u);
      const unsigned tg = og / nx;
      if (og + 1u == (tg + 1u) * nx) xb_add(&bar[XB_TOPGEN], 1u);
      else XB_SPIN(xb_ld(&bar[XB_TOPGEN]) == tg, bar);
      __builtin_amdgcn_fence(__ATOMIC_ACQUIRE, "agent");
      xb_add(&bar[XB_XGEN(b.x)], 1u);
      asm volatile("s_waitcnt vmcnt(0)" ::: "memory");
    } else {
      XB_SPIN(xb_ld(&bar[XB_XGEN(b.x)]) == gen, bar);
      __builtin_amdgcn_fence(__ATOMIC_ACQUIRE, "agent");
      asm volatile("s_waitcnt vmcnt(0)" ::: "memory");
    }
  }
  __syncthreads();
}

__global__ void __launch_bounds__(NTHR, 2) fwd_kernel(Params p) {
  const u16* WT = (const u16*)p.ws;
  const u16* XN = (const u16*)(p.ws + OFF_XN);
  const u16* Zc = (const u16*)(p.ws + OFF_Z);
  XcdBarrier xb;
  if (p.coop == 1) {
    volatile LAS unsigned* st = (volatile LAS unsigned*)(smem + LDS_BYTES - 16);
    if (threadIdx.x == 0) { st[0] = 0u; st[1] = 0u; }
    __syncthreads();
    xb = xcd_barrier_post((unsigned*)(p.ws + OFF_BAR), st);
  }
  for (int ph = p.phase_lo; ph < p.phase_hi; ph++) {
    if (ph == 0) {
      convert_weights(p, 0);
    } else if (ph == 23) {
      norm_phase<4>(p, 0, p.final_norm_g);
    } else {
      const int l = (ph - 1) / 11, sub = (ph - 1) % 11;
      switch (sub) {
        case 0:
          if (l == 0) norm_phase<0>(p, l, p.norm1_g);
          else { convert_weights(p, l); norm_phase<1>(p, l, p.norm1_g + (size_t)l * 1024); }
          break;
        case 1: gemm_phase<0>(p, l, XN, 1024, WT + WT_IN, 1024, 4096, 1024); break;
        case 2:
          for (int t = blockIdx.x; t < 2304; t += gridDim.x) {
            int type, idx;
            if (t < 2048) { type = (t >> 9) & 1; idx = (t >> 10) * 512 + (t & 511); }
            else { type = t & 1; idx = 1024 + ((t - 2048) >> 1); }
            const int h = idx & 3, chunk = idx >> 2;
            if (type) c2_delta(p, l, chunk, h); else c2_ret(p, l, chunk, h);
          }
          break;
        case 3: scan_phase(p, l); break;
        case 4: fin_phase(p, l); break;
        case 5: gemm_phase<1>(p, l, XN, 1024, WT + WT_OUT, 1024, 1024, 1024); break;
        case 6: norm_phase<2>(p, l, p.norm2_g + (size_t)l * 1024); break;
        case 7: gemm_phase<2>(p, l, XN, 1024, (l == 1 && gridDim.x >= 128) ? (const u16*)(p.ws + OFF_WUP1) : WT + WT_UP, 1024, 4096, 1024); break;
        case 8: gemm_phase<1>(p, l, Zc, 4096, WT + WT_DOWN, 4096, 1024, 4096); break;
        case 9: norm_phase<3>(p, l, p.ple_norm_g + (size_t)l * 1024); break;
        case 10: gemm_phase<3>(p, l, XN, 1024, WT + WT_GATE, 1024, 1024, 1024); break;
      }
    }
    if (ph + 1 < p.phase_hi) {
      if (p.coop == 1) xcd_barrier(xb);
      else if (p.coop == 2) cg::this_grid().sync();
    }
  }
}

extern "C" void kernel_launch(void* const* d_in, const int* in_sizes, int n_in, void* d_out, int out_size, void* d_ws,
                              size_t ws_size, hipStream_t stream) {
  static int grid_blocks = 0;
  if (!grid_blocks) {
    int dev = 0, cus = 0, per_cu = 0;
    hipGetDevice(&dev);
    hipDeviceGetAttribute(&cus, hipDeviceAttributeMultiprocessorCount, dev);
    hipFuncSetAttribute((const void*)fwd_kernel, hipFuncAttributeMaxDynamicSharedMemorySize, LDS_BYTES);
    hipOccupancyMaxActiveBlocksPerMultiprocessor(&per_cu, fwd_kernel, NTHR, LDS_BYTES);
    if (per_cu < 1) per_cu = 1;
    if (per_cu > 2) per_cu = 2;
    grid_blocks = cus * per_cu;
  }
  Params p{};
  const float** f = (const float**)&p;
  for (int i = 0; i < 23; i++) f[i] = (const float*)d_in[i];
  p.out = (float*)d_out;
  p.ws = (char*)d_ws;
  p.pad = 0;
#ifndef ONE_LAUNCH
  p.coop = 0;
  for (int ph = 0; ph < 24; ph++) {
    p.phase_lo = ph;
    p.phase_hi = ph + 1;
    hipLaunchKernelGGL(fwd_kernel, dim3(grid_blocks), dim3(NTHR), LDS_BYTES, stream, p);
  }
#else
  p.coop = 1;
  hipMemsetAsync((char*)d_ws + OFF_BAR, 0, XCD_BAR_WORDS * 4, stream);
  p.phase_lo = 0;
  p.phase_hi = 24;
  void* args[] = {&p};
  hipError_t e = hipLaunchCooperativeKernel((void*)fwd_kernel, dim3(grid_blocks), dim3(NTHR), args, LDS_BYTES, stream);
  if (e != hipSuccess) fprintf(stderr, "cooperative launch failed: %s (grid %d)\n", hipGetErrorString(e), grid_blocks);
#endif
}
```

```cpp
#include <hip/hip_runtime.h>
#define ONE_LAUNCH 1
#include <hip/hip_bf16.h>
#include <hip/hip_cooperative_groups.h>
#include <cstdio>
namespace cg = cooperative_groups;

typedef unsigned short u16;
using bf16x8 = __attribute__((ext_vector_type(8))) short;
using bf16x4 = __attribute__((ext_vector_type(4))) short;
using f32x4 = __attribute__((ext_vector_type(4))) float;
using f32x16 = __attribute__((ext_vector_type(16))) float;
#define DEVI __device__ __forceinline__

constexpr int NTOK = 18432, NPR = 16384, DM = 1024, ZC = 4096;
constexpr int NTHR = 256;
constexpr int LDS_BYTES = 73728;
constexpr float EPS = 1e-6f;

constexpr size_t WT_IN = 0, WT_OUT = 4194304, WT_UP = 5242880, WT_DOWN = 9437184, WT_PROJ = 13631488,
                 WT_GATE = 13893632, WT_END = 14942208;
constexpr size_t OFF_WSM = WT_END * 2;
constexpr size_t OFF_XN = OFF_WSM + 65536;
constexpr size_t OFF_Z = OFF_XN + 37748736;
constexpr size_t OFF_UTD = OFF_Z + 150994944;
constexpr size_t OFF_ATT = OFF_UTD + 18874368;
constexpr size_t OFF_ZB = OFF_ATT + 18874368;
constexpr size_t OFF_ZS = OFF_ZB + 2654208;
constexpr size_t OFF_GE = OFF_ZS + 589824;
constexpr size_t OFF_BAR = OFF_GE + 8192;
constexpr size_t OFF_TB = OFF_BAR + 16384;
constexpr size_t O_RETP = 18874368, O_DNP = 19136512, O_CONVP = 19398656, O_RETS = 19417088,
                 O_DNS = 23611392, O_CONVS = 27805696;

struct Params {
  const float *x_prompt, *x_sample, *p_prompt, *p_sample, *state_ret, *state_delta, *state_conv;
  const float *norm1_g, *w_in, *conv_w, *dt_bias, *a_log, *ret_norm_g, *dn_norm_g, *w_out, *norm2_g, *w_up,
      *w_down, *ple_proj, *ple_norm_g, *ple_gate_w, *ple_gate_b, *final_norm_g;
  float* out;
  char* ws;
  int phase_lo, phase_hi, coop, pad;
};

extern __shared__ __attribute__((aligned(16))) char smem[];

typedef const __attribute__((address_space(1))) bf16x8* gptr8;
DEVI bf16x8 ldg8(const u16* p) { return *(gptr8)(p); }
DEVI int otid() {
  int t = threadIdx.x;
  asm volatile("" : "+v"(t));
  return t;
}
typedef __bf16 bf2v __attribute__((ext_vector_type(2)));
typedef float f2v __attribute__((ext_vector_type(2)));
typedef unsigned u32x2 __attribute__((ext_vector_type(2)));
DEVI unsigned pk2(float a, float b) {
  f2v v = {a, b};
  bf2v r = __builtin_convertvector(v, bf2v);
  return __builtin_bit_cast(unsigned, r);
}
DEVI u16 f2bf(float f) { return (u16)(pk2(f, 0.f) & 0xffffu); }
DEVI float bf2f(u16 h) { return __uint_as_float(((unsigned)h) << 16); }
DEVI float bfs(short h) { return __uint_as_float(((unsigned)(u16)h) << 16); }
DEVI float wave_sum(float v) {
#pragma unroll
  for (int o = 32; o > 0; o >>= 1) v += __shfl_xor(v, o);
  return v;
}
DEVI float sigmoidf_(float x) { return 1.f / (1.f + __expf(-x)); }
DEVI f32x16 mfma32(bf16x8 a, bf16x8 b, f32x16 c) { return __builtin_amdgcn_mfma_f32_32x32x16_bf16(a, b, c, 0, 0, 0); }
DEVI f32x4 mfma16(bf16x8 a, bf16x8 b, f32x4 c) { return __builtin_amdgcn_mfma_f32_16x16x32_bf16(a, b, c, 0, 0, 0); }
DEVI bf16x4 pack4(float a, float b, float c, float d) {
  u32x2 t = {pk2(a, b), pk2(c, d)};
  return __builtin_bit_cast(bf16x4, t);
}

DEVI void cvt_tile(const float* __restrict__ W, int ldn, int k0, int n0, u16* __restrict__ Wt, int ldk) {
  float* tile = (float*)smem;
  const int tid = otid();
#pragma unroll
  for (int i = 0; i < 4; i++) {
    int kk = (tid >> 4) + 16 * i, n4 = (tid & 15) * 4;
    float4 v = *(const float4*)(W + (size_t)(k0 + kk) * ldn + n0 + n4);
    tile[kk * 65 + n4] = v.x; tile[kk * 65 + n4 + 1] = v.y; tile[kk * 65 + n4 + 2] = v.z; tile[kk * 65 + n4 + 3] = v.w;
  }
  __syncthreads();
  int n = tid >> 2, ks = (tid & 3) * 16;
  bf16x8 o0, o1;
#pragma unroll
  for (int e = 0; e < 8; e++) {
    o0[e] = (short)f2bf(tile[(ks + e) * 65 + n]);
    o1[e] = (short)f2bf(tile[(ks + 8 + e) * 65 + n]);
  }
  u16* dst = Wt + (size_t)(n0 + n) * ldk + k0 + ks;
  *(bf16x8*)dst = o0;
  *(bf16x8*)(dst + 8) = o1;
  __syncthreads();
}

__device__ void convert_weights(const Params& p, int l) {
  u16* WT = (u16*)p.ws;
  const int G = gridDim.x;
  for (int t = blockIdx.x; t < 3648; t += G) {
    if (t < 1024) {
      cvt_tile(p.w_in + (size_t)l * 1024 * 4104, 4104, (t >> 6) * 64, (t & 63) * 64, WT + WT_IN, 1024);
    } else if (t < 1280) {
      int u = t - 1024;
      cvt_tile(p.w_out + (size_t)l * 1048576, 1024, (u >> 4) * 64, (u & 15) * 64, WT + WT_OUT, 1024);
    } else if (t < 2304) {
      int u = t - 1280;
      cvt_tile(p.w_up + (size_t)l * 4194304, 4096, (u >> 6) * 64, (u & 63) * 64, WT + WT_UP, 1024);
    } else if (t < 3328) {
      int u = t - 2304;
      cvt_tile(p.w_down + (size_t)l * 4194304, 1024, (u >> 4) * 64, (u & 15) * 64, WT + WT_DOWN, 4096);
    } else if (t < 3392) {
      int u = t - 3328;
      cvt_tile(p.ple_proj + (size_t)l * 262144, 1024, (u >> 4) * 64, (u & 15) * 64, WT + WT_PROJ, 256);
    } else {
      int u = t - 3392;
      cvt_tile(p.ple_gate_w + (size_t)l * 1048576, 1024, (u >> 4) * 64, (u & 15) * 64, WT + WT_GATE, 1024);
    }
  }
  if (l == 0) {
    float2* TB = (float2*)(p.ws + OFF_TB);
    for (int i = blockIdx.x * NTHR + otid(); i < 4096; i += G * NTHR) {
      float inv = exp2f(-(float)(i & 63) * (13.287712379549449f / 64.f));
      float ang = (float)(i >> 6) * inv;
      TB[i] = make_float2(cosf(ang), sinf(ang));
    }
  }
}

template <int MODE>
__device__ void norm_phase(const Params& p, int l, const float* __restrict__ gain) {
  const int tid = otid();
  const int lane = tid & 63, w = tid >> 6;
  float* H = p.out;
  u16* XN = (u16*)(p.ws + OFF_XN);
  float* ZS = (float*)(p.ws + OFF_ZS);
  const float* wsm = (const float*)(smem + 20480);
  if (MODE == 0 || MODE == 1) {
    float* wl = (float*)(smem + 20480);
    const float* wsrc = p.w_in + (size_t)l * 1024 * 4104 + 4096;
#pragma unroll 4
    for (int it = 0; it < 32; it++) {
      const int idx = it * 256 + tid, k = idx >> 3, j = idx & 7;
      wl[j * 1024 + k] = wsrc[(size_t)k * 4104 + j];
    }
    __syncthreads();
  }
  for (int row = blockIdx.x * 4 + w; row < NTOK; row += gridDim.x * 4) {
    const float* src;
    if (MODE == 0) src = row < NPR ? p.x_prompt + (size_t)row * DM : p.x_sample + (size_t)(row - NPR) * DM;
    else src = H + (size_t)row * DM;
    float4 v[4];
    float ss = 0.f;
#pragma unroll
    for (int i = 0; i < 4; i++) {
      v[i] = *(const float4*)(src + i * 256 + lane * 4);
      ss += v[i].x * v[i].x + v[i].y * v[i].y + v[i].z * v[i].z + v[i].w * v[i].w;
    }
    ss = wave_sum(ss);
    float rstd = rsqrtf(ss * (1.f / 1024.f) + EPS);
    float4 y[4];
#pragma unroll
    for (int i = 0; i < 4; i++) {
      float4 g = *(const float4*)(gain + i * 256 + lane * 4);
      y[i].x = v[i].x * rstd * g.x; y[i].y = v[i].y * rstd * g.y; y[i].z = v[i].z * rstd * g.z; y[i].w = v[i].w * rstd * g.w;
    }
    if (MODE == 4) {
#pragma unroll
      for (int i = 0; i < 4; i++) *(float4*)(H + (size_t)row * DM + i * 256 + lane * 4) = y[i];
    } else {
#pragma unroll
      for (int i = 0; i < 4; i++)
        *(bf16x4*)(XN + (size_t)row * DM + i * 256 + lane * 4) = pack4(y[i].x, y[i].y, y[i].z, y[i].w);
    }
    if (MODE == 0 || MODE == 1) {
      float d[8];
#pragma unroll
      for (int j = 0; j < 8; j++) {
        float a = 0.f;
#pragma unroll
        for (int i = 0; i < 4; i++) {
          float4 wv = *(const float4*)(wsm + j * 1024 + i * 256 + lane * 4);
          a += y[i].x * wv.x + y[i].y * wv.y + y[i].z * wv.z + y[i].w * wv.w;
        }
        d[j] = wave_sum(a);
      }
      if (lane == 0) {
        *(float4*)(ZS + (size_t)row * 8) = make_float4(d[0], d[1], d[2], d[3]);
        *(float4*)(ZS + (size_t)row * 8 + 4) = make_float4(d[4], d[5], d[6], d[7]);
      }
    }
    if (MODE == 3) {
      u16* PB = (u16*)(p.ws + OFF_Z);
      const float* ps = row < NPR ? p.p_prompt + ((size_t)l * NPR + row) * 256
                                  : p.p_sample + ((size_t)l * 2048 + (row - NPR)) * 256;
      float4 pv = *(const float4*)(ps + lane * 4);
      *(bf16x4*)(PB + (size_t)row * 256 + lane * 4) = pack4(pv.x, pv.y, pv.z, pv.w);
    }
  }
}

DEVI int lds_byte(int r, int c) { return r * 128 + ((((c >> 3) ^ (r >> 1)) & 7) << 4) + (c & 7) * 2; }
DEVI void stage_rc(int b, int& R, int& C) {
  R = b >> 7;
  C = ((((b >> 4) ^ (R >> 1)) & 7) << 3);
}

DEVI void gemm_kloop(f32x4 (&acc)[4][4], const u16* __restrict__ A, int lda, const u16* __restrict__ Bt, int ldb,
                     int brow, int bcol, int K, bool pre, const u16* nA, int nlda, const u16* nBt, int nldb, int nbrow,
                     int nbcol) {
  const int tid = otid(), lane = tid & 63, wid = tid >> 6, wr = wid >> 1, wc = wid & 1, fr = lane & 15,
            fq = lane >> 4;
  const int nt = K / 64;
  int sr[4], sc[4];
#pragma unroll
  for (int i = 0; i < 4; i++) stage_rc(tid * 16 + i * 4096, sr[i], sc[i]);
  const u16* Ab = A + (size_t)brow * lda;
  const u16* Bb = Bt + (size_t)bcol * ldb;
#define GSTAGE(buf, kt)                                                                                         \
  do {                                                                                                          \
    _Pragma("unroll") for (int i = 0; i < 4; i++) {                                                             \
      int b_ = tid * 16 + i * 4096;                                                                             \
      __builtin_amdgcn_global_load_lds((const unsigned*)(Ab + (size_t)sr[i] * lda + (kt) * 64 + sc[i]),         \
                                       (unsigned*)(smem + (buf) * 32768 + b_), 16, 0, 0);                       \
      __builtin_amdgcn_global_load_lds((const unsigned*)(Bb + (size_t)sr[i] * ldb + (kt) * 64 + sc[i]),         \
                                       (unsigned*)(smem + (buf) * 32768 + 16384 + b_), 16, 0, 0);               \
    }                                                                                                           \
  } while (0)
#define GSTAGE_NEXT(buf, kt)                                                                                    \
  do {                                                                                                          \
    const u16* nAb_ = nA + (size_t)nbrow * nlda;                                                                \
    const u16* nBb_ = nBt + (size_t)nbcol * nldb;                                                               \
    _Pragma("unroll") for (int i = 0; i < 4; i++) {                                                             \
      int b_ = tid * 16 + i * 4096;                                                                             \
      __builtin_amdgcn_global_load_lds((const unsigned*)(nAb_ + (size_t)sr[i] * nlda + (kt) * 64 + sc[i]),      \
                                       (unsigned*)(smem + (buf) * 32768 + b_), 16, 0, 0);                       \
      __builtin_amdgcn_global_load_lds((const unsigned*)(nBb_ + (size_t)sr[i] * nldb + (kt) * 64 + sc[i]),      \
                                       (unsigned*)(smem + (buf) * 32768 + 16384 + b_), 16, 0, 0);               \
    }                                                                                                           \
  } while (0)
  if (!pre) { GSTAGE(0, 0); GSTAGE(1, 1); }
  for (int t = 0; t < nt; t++) {
    if (t > 0 && (t + 1 < nt || nA)) asm volatile("s_waitcnt vmcnt(8)" ::: "memory");
    else asm volatile("s_waitcnt vmcnt(0)" ::: "memory");
    __builtin_amdgcn_s_barrier();
    asm volatile("" ::: "memory");
    const char* sa = smem + (t & 1) * 32768;
    const char* sb = sa + 16384;
    bf16x8 af[4][2], bf[4][2];
#pragma unroll
    for (int m = 0; m < 4; m++)
#pragma unroll
      for (int k = 0; k < 2; k++) af[m][k] = *(const bf16x8*)(sa + lds_byte(wr * 64 + m * 16 + fr, k * 32 + fq * 8));
#pragma unroll
    for (int n = 0; n < 4; n++)
#pragma unroll
      for (int k = 0; k < 2; k++) bf[n][k] = *(const bf16x8*)(sb + lds_byte(wc * 64 + n * 16 + fr, k * 32 + fq * 8));
    asm volatile("s_waitcnt lgkmcnt(0)" ::: "memory");
    __builtin_amdgcn_s_barrier();
    asm volatile("" ::: "memory");
    if (t + 2 < nt) GSTAGE(t & 1, t + 2);
    else if (nA) GSTAGE_NEXT(t & 1, t + 2 - nt);
#pragma unroll
    for (int k = 0; k < 2; k++)
#pragma unroll
      for (int m = 0; m < 4; m++)
#pragma unroll
        for (int n = 0; n < 4; n++) acc[m][n] = mfma16(bf[n][k], af[m][k], acc[m][n]);
  }
#undef GSTAGE_NEXT
#undef GSTAGE
}

template <int EPI>
__device__ void gemm_phase(const Params& p, int l, const u16* A, int lda, const u16* Bt, int ldb, int N, int K) {
  const int tid = otid(), lane = tid & 63, wid = tid >> 6, wr = wid >> 1, wc = wid & 1, fr = lane & 15,
            fq = lane >> 4;
  const int nN = N / 128, ntile = (NTOK / 128) * nN;
  u16* Z = (u16*)(p.ws + OFF_Z);
  float* H = p.out;
  auto tile_of = [&](int t, int& tm, int& tn) -> bool {
    if (t >= ntile) return false;
    tn = t % nN; tm = t / nN;
    if (gridDim.x == 512) {
      const int k = t >> 9, x = blockIdx.x & 7, j = blockIdx.x >> 3;
      const int nsb = 18 * (nN >> 3), sb = k * 8 + x;
      if (k * 8 + 8 <= nsb) {
        const int tnb = sb % (nN >> 3), tmb = sb / (nN >> 3);
        tm = tmb * 8 + (j >> 3);
        tn = tnb * 8 + (j & 7);
      } else {
        if (j >= 16) return false;
        tm = 128 + x * 2 + (j >> 3);
        tn = j & 7;
      }
    }
    return true;
  };
  const u16* PBp = (const u16*)(p.ws + OFF_Z);
  const u16* WPp = (const u16*)p.ws + WT_PROJ;
  bool pre = false;
  for (int t = blockIdx.x; t < ntile; t += gridDim.x) {
    int tm, tn, ntm = 0, ntn = 0;
    if (!tile_of(t, tm, tn)) break;
    const bool has_next = tile_of(t + gridDim.x, ntm, ntn);
    const int brow = tm * 128, bcol = tn * 128;
    f32x4 acc[4][4];
#pragma unroll
    for (int m = 0; m < 4; m++)
#pragma unroll
      for (int n = 0; n < 4; n++) acc[m][n] = f32x4{0.f, 0.f, 0.f, 0.f};
    if (EPI != 3) {
      gemm_kloop(acc, A, lda, Bt, ldb, brow, bcol, K, pre, has_next ? A : nullptr, lda, Bt, ldb, ntm * 128, ntn * 128);
      pre = has_next;
    }
    if (EPI == 3) {
      u16* PP = (u16*)(p.ws + OFF_UTD);
      gemm_kloop(acc, PBp, 256, WPp, 256, brow, bcol, 256, pre, A, lda, Bt, ldb, brow, bcol);
#pragma unroll
      for (int m = 0; m < 4; m++)
#pragma unroll
        for (int n = 0; n < 4; n++) {
          int row = brow + wr * 64 + m * 16 + fr, col = bcol + wc * 64 + n * 16 + fq * 4;
          *(bf16x4*)(PP + (size_t)row * DM + col) = pack4(acc[m][n][0], acc[m][n][1], acc[m][n][2], acc[m][n][3]);
          acc[m][n] = f32x4{0.f, 0.f, 0.f, 0.f};
        }
      gemm_kloop(acc, A, lda, Bt, ldb, brow, bcol, K, true, has_next ? PBp : nullptr, 256, WPp, 256, ntm * 128, ntn * 128);
      pre = has_next;
#pragma unroll
      for (int m = 0; m < 4; m++)
#pragma unroll
        for (int n = 0; n < 4; n++) {
          int row = brow + wr * 64 + m * 16 + fr, col = bcol + wc * 64 + n * 16 + fq * 4;
          float4 b = *(const float4*)(p.ple_gate_b + (size_t)l * 1024 + col);
          float4* hp = (float4*)(H + (size_t)row * DM + col);
          float4 hv = *hp;
          const bf16x4 pq = *(const bf16x4*)(PP + (size_t)row * DM + col);
          hv.x += bfs(pq[0]) * sigmoidf_(acc[m][n][0] + b.x);
          hv.y += bfs(pq[1]) * sigmoidf_(acc[m][n][1] + b.y);
          hv.z += bfs(pq[2]) * sigmoidf_(acc[m][n][2] + b.z);
          hv.w += bfs(pq[3]) * sigmoidf_(acc[m][n][3] + b.w);
          *hp = hv;
        }
    } else {
#pragma unroll
      for (int m = 0; m < 4; m++)
#pragma unroll
        for (int n = 0; n < 4; n++) {
          int row = brow + wr * 64 + m * 16 + fr, col = bcol + wc * 64 + n * 16 + fq * 4;
          f32x4 a = acc[m][n];
          if (EPI == 0) {
            bf16x4 zb4 = pack4(a[0], a[1], a[2], a[3]);
            *(bf16x4*)(Z + (size_t)row * ZC + col) = zb4;
            int rr = (row & 63) - 61;
            if (rr >= 0 && col >= 2048 && col < 3584) {
              u16* ZB = (u16*)(p.ws + OFF_ZB);
              int ch = col - 2048;
              *(bf16x4*)(ZB + ((size_t)(row >> 6) * 3 + rr) * 1536 + ch) = zb4;
              if (row >= NPR) {
                int b = (row - NPR) >> 6;
                *(float4*)(p.out + O_CONVS + (((size_t)l * 32 + b) * 3 + rr) * 1536 + ch) = make_float4(a[0], a[1], a[2], a[3]);
              } else if ((row & 8191) >= 8189) {
                int b = row >> 13;
                *(float4*)(p.out + O_CONVP + (((size_t)l * 2 + b) * 3 + rr) * 1536 + ch) = make_float4(a[0], a[1], a[2], a[3]);
              }
            }
          } else if (EPI == 1) {
            float4* hp = (float4*)(H + (size_t)row * DM + col);
            const float* rs = (l == 0 && K == 1024)
                                  ? (row < NPR ? p.x_prompt + (size_t)row * DM + col : p.x_sample + (size_t)(row - NPR) * DM + col)
                                  : (const float*)hp;
            float4 hv = *(const float4*)rs;
            hv.x += a[0]; hv.y += a[1]; hv.z += a[2]; hv.w += a[3];
            *hp = hv;
          } else if (EPI == 2) {
            float r0 = fmaxf(a[0], 0.f), r1 = fmaxf(a[1], 0.f), r2 = fmaxf(a[2], 0.f), r3 = fmaxf(a[3], 0.f);
            *(bf16x4*)(Z + (size_t)row * ZC + col) = pack4(r0 * r0, r1 * r1, r2 * r2, r3 * r3);
          }
        }
    }
  }
}


template <int KS>
DEVI int fragA(int row, int k8) { return ((((row >> 5) * KS + (k8 >> 1)) * 2 + (k8 & 1)) * 32 + (row & 31)) * 8; }
DEVI int fragU(int dv, int tok) {
  return ((((dv >> 5) * 2 + (tok >> 5)) * 64 + ((tok >> 2) & 1) * 32 + (dv & 31)) * 16) + ((tok >> 3) & 3) * 4;
}
DEVI size_t slotaddr(int row0, int slot, int L) { return (size_t)(row0 + (L >> 7)) * ZC + slot + (L & 127); }

constexpr int LP = 136;

__device__ void c2_ret(const Params& p, int l, int chunk, int h) {
  u16* Z = (u16*)(p.ws + OFF_Z);
  u16* ATT = (u16*)(p.ws + OFF_ATT);
  int tid_ = threadIdx.x;
  asm volatile("" : "+v"(tid_));
  const int tid = tid_, lane = tid & 63, w = __builtin_amdgcn_readfirstlane(tid >> 6), r = lane & 31, hh = lane >> 5;
  u16* qs = (u16*)smem;
  u16* ks = qs + 64 * LP;
  u16* vs = ks + 64 * LP;
  const int row0 = chunk * 64;
  const bool is_sample = chunk >= 256;
  const int pos0 = is_sample ? 4096 : (chunk & 127) * 64;
  const float lg2 = log2f(1.f - exp2f(-5.f - (float)h));
  const int cq = h * 128, ck = 512 + h * 128, cv = 1024 + h * 128;
  {
    const float2* TB = (const float2*)(p.ws + OFF_TB);
    float2* ab = (float2*)(smem + 52224);
    bf16x8 q1[2], q2[2], k1[2], k2[2], vv[4];
#pragma unroll
    for (int it = 0; it < 2; it++) {
      int item = it * 256 + tid;
      int t = item >> 3, cg8 = (item & 7) * 8;
      size_t zr = (size_t)(row0 + t) * ZC;
      q1[it] = *(const bf16x8*)(Z + zr + cq + cg8); q2[it] = *(const bf16x8*)(Z + zr + cq + 64 + cg8);
      k1[it] = *(const bf16x8*)(Z + zr + ck + cg8); k2[it] = *(const bf16x8*)(Z + zr + ck + 64 + cg8);
    }
#pragma unroll
    for (int it = 0; it < 4; it++) {
      int item = it * 256 + tid;
      vv[it] = *(const bf16x8*)(Z + (size_t)(row0 + (item >> 4)) * ZC + cv + (item & 15) * 8);
    }
    if (tid < 64) {
      float inv = exp2f(-(float)tid * (13.287712379549449f / 64.f));
      float ang = (float)pos0 * inv;
      ab[tid] = make_float2(cosf(ang), sinf(ang));
    }
#pragma unroll
    for (int it = 0; it < 4; it++) {
      int item = it * 256 + tid;
      *(bf16x8*)(vs + (item >> 4) * LP + (item & 15) * 8) = vv[it];
    }
    __syncthreads();
#pragma unroll
    for (int it = 0; it < 2; it++) {
      int item = it * 256 + tid;
      int t = item >> 3, cg8 = (item & 7) * 8;
      bf16x8 sq1, sq2, sk1, sk2;
#pragma unroll
      for (int e = 0; e < 8; e++) {
        int d = cg8 + e;
        float2 B = TB[t * 64 + d], A = ab[d];
        float cs = A.x * B.x - A.y * B.y, sn = A.y * B.x + A.x * B.y;
        float a = bfs(q1[it][e]), b = bfs(q2[it][e]);
        float qa = a * cs - b * sn, qb = a * sn + b * cs;
        sq1[e] = (short)f2bf(qa); sq2[e] = (short)f2bf(qb);
        a = bfs(k1[it][e]); b = bfs(k2[it][e]);
        float ka = (a * cs - b * sn) * 0.08838834764831845f, kb = (a * sn + b * cs) * 0.08838834764831845f;
        sk1[e] = (short)f2bf(ka); sk2[e] = (short)f2bf(kb);
      }
      *(bf16x8*)(qs + t * LP + cg8) = sq1; *(bf16x8*)(qs + t * LP + 64 + cg8) = sq2;
      *(bf16x8*)(ks + t * LP + cg8) = sk1; *(bf16x8*)(ks + t * LP + 64 + cg8) = sk2;
    }
  }
  __syncthreads();
  {
    const int ib = w & 1, jb = w >> 1;
    f32x16 acc;
#pragma unroll
    for (int e = 0; e < 16; e++) acc[e] = 0.f;
#pragma unroll
    for (int kk = 0; kk < 8; kk++) {
      bf16x8 a = *(const bf16x8*)(ks + (jb * 32 + r) * LP + kk * 16 + hh * 8);
      bf16x8 b = *(const bf16x8*)(qs + (ib * 32 + r) * LP + kk * 16 + hh * 8);
      acc = mfma32(a, b, acc);
    }
    const int i = ib * 32 + r;
    u16* att = ATT + (size_t)(chunk * 4 + h) * 4096;
#pragma unroll
    for (int g = 0; g < 4; g++) {
      int j0 = jb * 32 + 8 * g + 4 * hh;
      float o[4];
#pragma unroll
      for (int e = 0; e < 4; e++) {
        int dj = i - (j0 + e);
        dj = dj < 0 ? -dj : dj;
        o[e] = acc[4 * g + e] * exp2f(lg2 * (float)dj);
      }
      *(bf16x4*)(att + fragA<4>(i, j0 >> 3) + (j0 & 7)) = pack4(o[0], o[1], o[2], o[3]);
    }
  }
#pragma unroll 1
  for (int it = 0; it < 4; it++) {
    int item = it * 256 + tid;
    int t = item >> 4, c16 = item & 15;
    bf16x8 v = *(const bf16x8*)(qs + t * LP + c16 * 8);
    float cross = exp2f(lg2 * (float)(t + 1));
    bf16x8 o;
#pragma unroll
    for (int e = 0; e < 8; e++) o[e] = (short)f2bf(bfs(v[e]) * cross);
    *(bf16x8*)(Z + slotaddr(row0, cq, fragA<8>(t, c16))) = o;
  }
  {
    const int d = tid & 127, half = tid >> 7;
#pragma unroll
    for (int q4 = 0; q4 < 4; q4++) {
      bf16x8 ok;
      bf16x4 ov0, ov1;
      const int t8 = half * 32 + q4 * 8;
#pragma unroll
      for (int e = 0; e < 8; e++) {
        int tt = t8 + e;
        ok[e] = (short)f2bf(bf2f(ks[tt * LP + d]) * exp2f(lg2 * (float)(63 - tt)));
        if (e < 4) ov0[e & 3] = (short)vs[tt * LP + d]; else ov1[e & 3] = (short)vs[tt * LP + d];
      }
      *(bf16x8*)(Z + slotaddr(row0, ck, fragA<4>(d, t8 >> 3))) = ok;
      *(bf16x4*)(Z + slotaddr(row0, cv, fragU(d, t8))) = ov0;
      *(bf16x4*)(Z + slotaddr(row0, cv, fragU(d, t8 + 4))) = ov1;
    }
  }
  __syncthreads();
}

__device__ void c2_delta(const Params& p, int l, int chunk, int h) {
  u16* Z = (u16*)(p.ws + OFF_Z);
  u16* ATT = (u16*)(p.ws + OFF_ATT);
  u16* UTD = (u16*)(p.ws + OFF_UTD);
  const u16* ZB = (const u16*)(p.ws + OFF_ZB);
  const float* ZS = (const float*)(p.ws + OFF_ZS);
  float* GE = (float*)(p.ws + OFF_GE);
  int tid_ = threadIdx.x;
  asm volatile("" : "+v"(tid_));
  const int tid = tid_, lane = tid & 63, w = __builtin_amdgcn_readfirstlane(tid >> 6), r = lane & 31, hh = lane >> 5;
  u16* qs = (u16*)smem;
  u16* ks = qs + 64 * LP;
  u16* vs = ks + 64 * LP;
  float* Af = (float*)(vs + 64 * LP);
  float* gcs = Af + 4096;
  float* su = gcs + 64;
  float* sw = su + 64;
  float* egq = sw + 64;
  float* egk = egq + 64;
  const int row0 = chunk * 64;
  const bool is_sample = chunk >= 256;
  const int nseq = is_sample ? 0 : (chunk & 127);
  const int sb = chunk - 256;
  if (w < 3) {
    const int part = w, tb = lane >> 4, cg8 = (lane & 15) * 8;
    const int ch = part * 512 + h * 128 + cg8;
    bf16x8 xr[19];
#pragma unroll
    for (int j = 0; j < 19; j++) {
      int tt = tb * 16 - 3 + j;
      tt = tt < 0 ? 0 : tt;
      xr[j] = *(const bf16x8*)(Z + (size_t)(row0 + tt) * ZC + 2048 + ch);
    }
    float4 cw0[4], cw1[4];
#pragma unroll
    for (int i = 0; i < 4; i++) {
      const float* cw = p.conv_w + ((size_t)l * 4 + i) * 1536 + ch;
      cw0[i] = *(const float4*)cw;
      cw1[i] = *(const float4*)(cw + 4);
    }
    if (tb == 0) {
#pragma unroll
      for (int j = 0; j < 3; j++) {
        if (is_sample) {
          const float* s = p.state_conv + (((size_t)l * 32 + sb) * 3 + j) * 1536 + ch;
          float4 s0 = *(const float4*)s, s1 = *(const float4*)(s + 4);
          u32x2 lo = {pk2(s0.x, s0.y), pk2(s0.z, s0.w)}, hi = {pk2(s1.x, s1.y), pk2(s1.z, s1.w)};
          bf16x4 l4 = __builtin_bit_cast(bf16x4, lo), h4 = __builtin_bit_cast(bf16x4, hi);
          xr[j] = bf16x8{l4[0], l4[1], l4[2], l4[3], h4[0], h4[1], h4[2], h4[3]};
        } else if (nseq > 0) {
          xr[j] = *(const bf16x8*)(ZB + ((size_t)(chunk - 1) * 3 + j) * 1536 + ch);
        } else {
          xr[j] = bf16x8{0, 0, 0, 0, 0, 0, 0, 0};
        }
      }
    }
    u16* dst = part == 0 ? qs : (part == 1 ? ks : vs);
#pragma unroll
    for (int i = 0; i < 16; i++) {
      float a[8];
#pragma unroll
      for (int e = 0; e < 8; e++) a[e] = 0.f;
#pragma unroll
      for (int tp = 0; tp < 4; tp++) {
        const bf16x8 v = xr[i + tp];
        a[0] += bfs(v[0]) * cw0[tp].x; a[1] += bfs(v[1]) * cw0[tp].y; a[2] += bfs(v[2]) * cw0[tp].z; a[3] += bfs(v[3]) * cw0[tp].w;
        a[4] += bfs(v[4]) * cw1[tp].x; a[5] += bfs(v[5]) * cw1[tp].y; a[6] += bfs(v[6]) * cw1[tp].z; a[7] += bfs(v[7]) * cw1[tp].w;
      }
      float ss = 0.f;
#pragma unroll
      for (int e = 0; e < 8; e++) {
        a[e] = a[e] * sigmoidf_(a[e]);
        ss += a[e] * a[e];
      }
      if (part < 2) {
        ss += __shfl_xor(ss, 1); ss += __shfl_xor(ss, 2); ss += __shfl_xor(ss, 4); ss += __shfl_xor(ss, 8);
        float sc = rsqrtf(ss + EPS) * (part == 0 ? 0.08838834764831845f : 1.f);
#pragma unroll
        for (int e = 0; e < 8; e++) a[e] *= sc;
      }
      u32x2 lo = {pk2(a[0], a[1]), pk2(a[2], a[3])}, hi = {pk2(a[4], a[5]), pk2(a[6], a[7])};
      *(u32x2*)(dst + (tb * 16 + i) * LP + cg8) = lo;
      *(u32x2*)(dst + (tb * 16 + i) * LP + cg8 + 4) = hi;
    }
  }
  if (w == 3) {
    const int row = row0 + lane;
    float bb = ZS[(size_t)row * 8 + h], ab = ZS[(size_t)row * 8 + 4 + h];
    float beta = sigmoidf_(bb);
    float x = ab + p.dt_bias[l * 4 + h];
    float sp = x > 20.f ? x : log1pf(expf(x));
    float gc = -expf(p.a_log[l * 4 + h]) * sp;
#pragma unroll
    for (int o = 1; o < 64; o <<= 1) {
      float v = __shfl_up(gc, o);
      if (lane >= o) gc += v;
    }
    float gl = __shfl(gc, 63);
    gcs[lane] = gc;
    su[lane] = beta;
    sw[lane] = beta * expf(gc);
    egq[lane] = expf(gc);
    egk[lane] = expf(gl - gc);
    if (lane == 63) GE[chunk * 4 + h] = expf(gc);
  }
  __syncthreads();
  {
    const int ib = w & 1, jb = w >> 1;
    const int i = ib * 32 + r;
    u16* att = ATT + (size_t)(1152 + chunk * 4 + h) * 4096;
    if (jb <= ib) {
      f32x16 aK, aQ;
#pragma unroll
      for (int e = 0; e < 16; e++) { aK[e] = 0.f; aQ[e] = 0.f; }
#pragma unroll
      for (int kk = 0; kk < 8; kk++) {
        bf16x8 a = *(const bf16x8*)(ks + (jb * 32 + r) * LP + kk * 16 + hh * 8);
        bf16x8 bk = *(const bf16x8*)(ks + (ib * 32 + r) * LP + kk * 16 + hh * 8);
        bf16x8 bq = *(const bf16x8*)(qs + (ib * 32 + r) * LP + kk * 16 + hh * 8);
        aK = mfma32(a, bk, aK);
        aQ = mfma32(a, bq, aQ);
      }
      const float gi = gcs[i], bi = su[i];
#pragma unroll
      for (int g = 0; g < 4; g++) {
        int j0 = jb * 32 + 8 * g + 4 * hh;
        float oa[4], oq[4];
#pragma unroll
        for (int e = 0; e < 4; e++) {
          int j = j0 + e;
          float dec = (i >= j) ? expf(gi - gcs[j]) : 0.f;
          oa[e] = (i > j) ? aK[4 * g + e] * bi * dec : 0.f;
          oq[e] = aQ[4 * g + e] * dec;
        }
        *(float4*)(Af + i * 64 + j0) = make_float4(oa[0], oa[1], oa[2], oa[3]);
        *(bf16x4*)(att + fragA<4>(i, j0 >> 3) + (j0 & 7)) = pack4(oq[0], oq[1], oq[2], oq[3]);
      }
    } else {
#pragma unroll
      for (int g = 0; g < 4; g++) {
        int j0 = jb * 32 + 8 * g + 4 * hh;
        *(float4*)(Af + i * 64 + j0) = make_float4(0.f, 0.f, 0.f, 0.f);
        *(bf16x4*)(att + fragA<4>(i, j0 >> 3) + (j0 & 7)) = bf16x4{0, 0, 0, 0};
      }
    }
  }
  __syncthreads();
  {
#pragma unroll 1
    for (int it = 0; it < 4; it++) {
      int item = it * 256 + tid;
      int t = item >> 4, c8 = (item & 15) * 8;
      bf16x8 v = *(const bf16x8*)(qs + t * LP + c8);
      float sc = egq[t];
      bf16x8 o;
#pragma unroll
      for (int e = 0; e < 8; e++) o[e] = (short)f2bf(bfs(v[e]) * sc);
      *(bf16x8*)(Z + slotaddr(row0, 2560 + h * 128, fragA<8>(t, c8 >> 3))) = o;
    }
    const int d = tid & 127, half = tid >> 7;
#pragma unroll
    for (int q4 = 0; q4 < 4; q4++) {
      bf16x8 ok;
#pragma unroll
      for (int e = 0; e < 8; e++) {
        int tt = half * 32 + q4 * 8 + e;
        ok[e] = (short)f2bf(bf2f(ks[tt * LP + d]) * egk[tt]);
      }
      *(bf16x8*)(Z + slotaddr(row0, 3072 + h * 128, fragA<4>(d, (half * 32 + q4 * 8) >> 3))) = ok;
    }
  }
  __syncthreads();
  {
    const int cc = tid & 127;
    const u16* src = (tid < 128) ? vs : ks;
    const float* scl = (tid < 128) ? su : sw;
    float x[64];
    int vzero;
    asm volatile("v_mov_b32 %0, 0" : "=v"(vzero));
    const float* Afv = Af + vzero;
    const float* sclv = scl + vzero;
#pragma unroll
    for (int i = 0; i < 64; i++) {
      float acc = bf2f(src[i * LP + cc]) * sclv[i], acc2 = 0.f;
#pragma unroll
      for (int j4 = 0; j4 < (i + 3) / 4; j4++) {
        float4 av = *(const float4*)(Afv + i * 64 + j4 * 4);
        if (j4 * 4 + 0 < i) acc -= av.x * x[j4 * 4 + 0];
        if (j4 * 4 + 1 < i) acc2 -= av.y * x[j4 * 4 + 1];
        if (j4 * 4 + 2 < i) acc -= av.z * x[j4 * 4 + 2];
        if (j4 * 4 + 3 < i) acc2 -= av.w * x[j4 * 4 + 3];
      }
      x[i] = acc + acc2;
      __builtin_amdgcn_sched_barrier(0);
    }
    if (tid < 128) {
      u16* ut = UTD + (size_t)(chunk * 4 + h) * 8192;
#pragma unroll
      for (int q4 = 0; q4 < 16; q4++)
        *(bf16x4*)(ut + fragU(cc, q4 * 4)) = pack4(x[q4 * 4], x[q4 * 4 + 1], x[q4 * 4 + 2], x[q4 * 4 + 3]);
    } else {
#pragma unroll
      for (int i = 0; i < 64; i++) qs[i * LP + cc] = f2bf(x[i]);
    }
  }
  __syncthreads();
#pragma unroll 1
  for (int it = 0; it < 4; it++) {
    int item = it * 256 + tid;
    int t = item >> 4, c8 = (item & 15) * 8;
    *(bf16x8*)(Z + slotaddr(row0, 2048 + h * 128, fragA<8>(t, c8 >> 3))) = *(const bf16x8*)(qs + t * LP + c8);
  }
  __syncthreads();
}

constexpr int STP = 136, VNP = 72, OBP = 40;
__device__ void scan_task(const Params& p, int l, int type, int seq, int h, int s) {
  const u16* Z = (const u16*)(p.ws + OFF_Z);
  const u16* ATT = (const u16*)(p.ws + OFF_ATT);
  const u16* UTD = (const u16*)(p.ws + OFF_UTD);
  const float* GE = (const float*)(p.ws + OFF_GE);
  u16* XN = (u16*)(p.ws + OFF_XN);
  const int tid = otid(), lane = tid & 63, w = __builtin_amdgcn_readfirstlane(tid >> 6), r = lane & 31, hh = lane >> 5;
  u16* ST = (u16*)smem;
  u16* VNT = ST + 32 * STP;
  u16* OB = VNT + 32 * VNP;
  const int nchunks = seq < 2 ? 128 : 1;
  const int chunk0 = seq < 2 ? seq * 128 : 256 + (seq - 2);
  const int dv0 = s * 32;
  const int c0 = type ? 2048 + h * 128 : h * 128;
  const int c1 = c0 + 512, c2 = c0 + 1024;
  const int colA8 = (w < 2) ? c0 : (type ? c1 : c0);
  const int colKT = type ? c2 : c1;
  const int mb = w & 1;
  const float carry = exp2f(64.f * log2f(1.f - exp2f(-5.f - (float)h)));
  f32x16 S;
  if (seq < 2) {
#pragma unroll
    for (int e = 0; e < 16; e++) S[e] = 0.f;
  } else {
    const float* s0 = (type ? p.state_delta : p.state_ret) + (((size_t)l * 32 + (seq - 2)) * 4 + h) * 16384;
#pragma unroll
    for (int e = 0; e < 16; e++) {
      int dk = w * 32 + (e & 3) + 8 * (e >> 2) + 4 * hh;
      S[e] = s0[(size_t)dk * 128 + dv0 + r];
    }
  }
#pragma unroll
  for (int g = 0; g < 4; g++)
    *(bf16x4*)(ST + r * STP + w * 32 + 8 * g + 4 * hh) = pack4(S[4 * g], S[4 * g + 1], S[4 * g + 2], S[4 * g + 3]);

  struct Ops { bf16x8 F8[8]; bf16x8 F4[4]; bf16x8 KT[4]; };
  const bool needA8 = (w >= 2) || type;
  auto load_ops = [&](Ops& o, int chunk) {
    const u16* zb = Z + (size_t)(chunk * 64 + (lane >> 4)) * ZC + (lane & 15) * 8;
    asm volatile("" : "+v"(zb));
    {
      const u16* a8 = zb + (size_t)(mb * 32) * ZC + colA8;
#pragma unroll
      for (int ks = 0; ks < 8; ks++) o.F8[ks] = ldg8(a8 + (size_t)(ks * 4) * ZC);
    }
    {
      const u16* f4p;
      int f4s;
      if (w >= 2) {
        f4p = ATT + (size_t)(type * 1152 + chunk * 4 + h) * 4096 + (mb * 256 + lane) * 8;
        f4s = 512;
      } else {
        const int L_ = ((s * 2 + mb) * 64 + lane) * 16;
        f4p = type ? UTD + (size_t)(chunk * 4 + h) * 8192 + L_ : Z + slotaddr(chunk * 64, c2, L_);
        f4s = 8;
      }
#pragma unroll
      for (int ks = 0; ks < 4; ks++) o.F4[ks] = ldg8(f4p + ((w >= 2) ? ks : (ks & 1)) * f4s);
    }
    {
      const u16* kt = zb + (size_t)(w * 16) * ZC + colKT;
#pragma unroll
      for (int ks = 0; ks < 4; ks++) o.KT[ks] = ldg8(kt + (size_t)(ks * 4) * ZC);
    }
  };
#define LBAR() do { asm volatile("s_waitcnt lgkmcnt(0)" ::: "memory"); __builtin_amdgcn_s_barrier(); asm volatile("" ::: "memory"); } while (0)
  auto step = [&](const Ops& o, int chunk, float ge) {
    f32x16 acc;
#pragma unroll
    for (int e = 0; e < 16; e++) acc[e] = 0.f;
    if (needA8) {
      f32x16 acc2;
#pragma unroll
      for (int e = 0; e < 16; e++) acc2[e] = 0.f;
      bf16x8 sb[8];
#pragma unroll
      for (int ks = 0; ks < 8; ks++) sb[ks] = *(const bf16x8*)(ST + r * STP + ks * 16 + hh * 8);
#pragma unroll
      for (int ks = 0; ks < 8; ks += 2) {
        acc = mfma32(o.F8[ks], sb[ks], acc);
        acc2 = mfma32(o.F8[ks + 1], sb[ks + 1], acc2);
      }
#pragma unroll
      for (int e = 0; e < 16; e++) acc[e] += acc2[e];
    }
    if (w < 2) {
#pragma unroll
      for (int g = 0; g < 4; g++) {
        const bf16x8 uu = o.F4[g >> 1];
        const int ub = (g & 1) * 4;
        float v0 = bfs(uu[ub]) - acc[4 * g], v1 = bfs(uu[ub + 1]) - acc[4 * g + 1], v2 = bfs(uu[ub + 2]) - acc[4 * g + 2],
              v3 = bfs(uu[ub + 3]) - acc[4 * g + 3];
        *(bf16x4*)(VNT + r * VNP + mb * 32 + 8 * g + 4 * hh) = pack4(v0, v1, v2, v3);
      }
    }
    LBAR();
    bf16x8 vb[4];
#pragma unroll
    for (int ks = 0; ks < 4; ks++) vb[ks] = *(const bf16x8*)(VNT + r * VNP + ks * 16 + hh * 8);
#pragma unroll
    for (int e = 0; e < 16; e++) S[e] *= ge;
#pragma unroll
    for (int ks = 0; ks < 4; ks++) S = mfma32(o.KT[ks], vb[ks], S);
#pragma unroll
    for (int g = 0; g < 4; g++)
      *(bf16x4*)(ST + r * STP + w * 32 + 8 * g + 4 * hh) = pack4(S[4 * g], S[4 * g + 1], S[4 * g + 2], S[4 * g + 3]);
    if (w >= 2) {
#pragma unroll
      for (int ks = 0; ks < 4; ks++) acc = mfma32(o.F4[ks], vb[ks], acc);
      u16* op = XN + (size_t)(chunk * 64 + mb * 32) * DM + type * 512 + h * 128 + dv0 + r;
#pragma unroll
      for (int e = 0; e < 16; e++) {
        const int tok = (e & 3) + 8 * (e >> 2) + 4 * hh;
        const unsigned val = f2bf(acc[e]);
        asm volatile("global_store_short %0, %1, off" ::"v"(op + (size_t)tok * DM), "v"(val) : "memory");
      }
    }
    LBAR();
  };
  float gev0 = carry, gev1 = carry;
  if (type) {
    gev0 = (lane < nchunks) ? GE[(chunk0 + lane) * 4 + h] : 1.f;
    gev1 = (64 + lane < nchunks) ? GE[(chunk0 + 64 + lane) * 4 + h] : 1.f;
  }
  auto flush = [&](int cbase, int nst) {
    for (int it = tid; it < nst * 256; it += 256) {
      int st = it >> 8, tok = (it >> 2) & 63, pc = it & 3;
      bf16x8 v = *(const bf16x8*)(OB + (((cbase + st) & 7) * 64 + tok) * OBP + pc * 8);
      *(bf16x8*)(XN + (size_t)((cbase + st) * 64 + tok) * DM + type * 512 + h * 128 + dv0 + pc * 8) = v;
    }
    __builtin_amdgcn_s_waitcnt(0x0F70);
  };
  Ops A, B;
  load_ops(A, chunk0);
  __syncthreads();
#define GEV(n_) __uint_as_float(__builtin_amdgcn_readlane(__float_as_uint((n_) < 64 ? gev0 : gev1), (n_) & 63))
  int n = 0;
#pragma unroll 1
  for (; n + 2 < nchunks; n += 2) {
    load_ops(B, chunk0 + n + 1);
    step(A, chunk0 + n, GEV(n));
    load_ops(A, chunk0 + n + 2);
    step(B, chunk0 + n + 1, GEV(n + 1));
  }
  if (n + 1 < nchunks) {
    load_ops(B, chunk0 + n + 1);
    step(A, chunk0 + n, GEV(n));
    step(B, chunk0 + n + 1, GEV(n + 1));
  } else {
    step(A, chunk0 + n, GEV(n));
  }
#undef GEV
#undef LBAR
  float* so;
  if (seq < 2) so = p.out + (type ? O_DNP : O_RETP) + (((size_t)l * 2 + seq) * 4 + h) * 16384;
  else so = p.out + (type ? O_DNS : O_RETS) + (((size_t)l * 32 + (seq - 2)) * 4 + h) * 16384;
#pragma unroll
  for (int e = 0; e < 16; e++) {
    int dk = w * 32 + (e & 3) + 8 * (e >> 2) + 4 * hh;
    so[(size_t)dk * 128 + dv0 + r] = S[e];
  }
  __syncthreads();
}

__device__ void scan_phase(const Params& p, int l) {
  const int G = gridDim.x, b = blockIdx.x;
  if (G >= 128) {
    if (b < 64) {
      int type = (b < 32) ? 1 : 0;
      int bh = b & 7, s = (b >> 3) & 3;
      scan_task(p, l, type, bh >> 2, bh & 3, s);
    } else {
      for (int u = b - 64; u < 1024; u += G - 64) {
        int type = u & 1, s = (u >> 1) & 3, h = (u >> 3) & 3, bb = u >> 5;
        scan_task(p, l, type, 2 + bb, h, s);
      }
    }
  } else {
    for (int t = b; t < 1088; t += G) {
      if (t < 64) {
        int type = (t < 32) ? 1 : 0;
        int bh = t & 7, s = (t >> 3) & 3;
        scan_task(p, l, type, bh >> 2, bh & 3, s);
      } else {
        int u = t - 64;
        int type = u & 1, s = (u >> 1) & 3, h = (u >> 3) & 3, bb = u >> 5;
        scan_task(p, l, type, 2 + bb, h, s);
      }
    }
  }
}

__device__ void fin_phase(const Params& p, int l) {
  const int tid = otid();
  const int lane = tid & 63, w = tid >> 6;
  u16* XN = (u16*)(p.ws + OFF_XN);
  const u16* Z = (const u16*)(p.ws + OFF_Z);
  for (int row = blockIdx.x * 4 + w; row < NTOK; row += gridDim.x * 4) {
    u16* op = XN + (size_t)row * DM + lane * 16;
    bf16x8 o0 = *(const bf16x8*)op, o1 = *(const bf16x8*)(op + 8);
    float v[16];
#pragma unroll
    for (int e = 0; e < 8; e++) { v[e] = bfs(o0[e]); v[8 + e] = bfs(o1[e]); }
    const bool ret = lane < 32;
    float s1 = 0.f, s2 = 0.f;
#pragma unroll
    for (int e = 0; e < 16; e++) { s1 += v[e]; s2 += v[e] * v[e]; }
    s1 += __shfl_xor(s1, 1); s1 += __shfl_xor(s1, 2); s1 += __shfl_xor(s1, 4);
    s2 += __shfl_xor(s2, 1); s2 += __shfl_xor(s2, 2); s2 += __shfl_xor(s2, 4);
    float mu = ret ? s1 * (1.f / 128.f) : 0.f;
    float var = s2 * (1.f / 128.f) - mu * mu;
    var = fmaxf(var, 0.f);
    float rstd = rsqrtf(var + EPS);
    const int col = lane * 16;
    const u16* gp = Z + (size_t)row * ZC + (ret ? 1536 + col : 3584 + (col - 512));
    bf16x8 g0 = *(const bf16x8*)gp, g1 = *(const bf16x8*)(gp + 8);
    const float* ng = ret ? p.ret_norm_g + (size_t)l * 512 + col : p.dn_norm_g + (size_t)l * 128 + (col & 127);
    bf16x8 r0, r1;
#pragma unroll
    for (int e = 0; e < 16; e++) {
      float gt = bfs(e < 8 ? g0[e & 7] : g1[e & 7]);
      float y = (v[e] - mu) * rstd * ng[e] * (gt * sigmoidf_(gt));
      if (e < 8) r0[e & 7] = (short)f2bf(y); else r1[e & 7] = (short)f2bf(y);
    }
    *(bf16x8*)op = r0;
    *(bf16x8*)(op + 8) = r1;
  }
}


#define XB_TMO      128
#define XB_XCNT(j)  (256  + 64 * (j))
#define XB_XSUB(j)  (1280 + 64 * (j))
#define XB_XGEN(j)  (2304 + 64 * (j))
#define XB_TOP      3328
#define XB_TOPGEN   3392
#define XCD_BAR_WORDS 3456
#define XB_SPIN_CAP (1u << 22)
#define LAS __attribute__((address_space(3)))
DEVI unsigned xb_ld(unsigned* p) { return __hip_atomic_load(p, __ATOMIC_RELAXED, __HIP_MEMORY_SCOPE_AGENT); }
DEVI unsigned xb_add(unsigned* p, unsigned v) { return __hip_atomic_fetch_add(p, v, __ATOMIC_RELAXED, __HIP_MEMORY_SCOPE_AGENT); }
DEVI unsigned xb_xcc_id() { return (unsigned)__builtin_amdgcn_s_getreg((3 << 11) | 20) & 0xFu; }
#define XB_SPIN(cond, bar) do { unsigned _sp = 0; while (cond) { __builtin_amdgcn_s_sleep(1); \
    if ((++_sp & 255u) == 0u) { if (xb_ld(&(bar)[XB_TMO])) break; if (_sp > XB_SPIN_CAP) { atomicAdd(&(bar)[XB_TMO], 1u); break; } } } } while (0)
struct XcdBarrier { unsigned* bar; unsigned x; volatile LAS unsigned* st; };
DEVI XcdBarrier xcd_barrier_post(unsigned* bar, volatile LAS unsigned* st) {
  XcdBarrier b; b.bar = bar; b.x = xb_xcc_id(); b.st = st;
  if (threadIdx.x == 0) (void)xb_add(&bar[XB_XCNT(b.x)], 1u);
  return b;
}
DEVI void xcd_barrier_complete(unsigned* bar, unsigned x, unsigned& nloc, unsigned& nx) {
  const unsigned G = gridDim.x * gridDim.y * gridDim.z;
  unsigned sum, cnt, mine, sp = 0u;
  for (;;) {
    sum = 0u; cnt = 0u; mine = 0u;
#pragma unroll
    for (unsigned j = 0; j < 16; ++j) { const unsigned c = xb_ld(&bar[XB_XCNT(j)]); sum += c; cnt += (c > 0u) ? 1u : 0u; mine = (j == x) ? c : mine; }
    if (sum == G) break;
    __builtin_amdgcn_s_sleep(1);
    if ((++sp & 255u) == 0u) { if (xb_ld(&bar[XB_TMO])) break; if (sp > XB_SPIN_CAP) { atomicAdd(&bar[XB_TMO], 1u); break; } }
  }
  nloc = mine > 0u ? mine : 1u; nx = cnt > 0u ? cnt : 1u;
}
DEVI void xcd_barrier(const XcdBarrier& b) {
  asm volatile("s_waitcnt vmcnt(0)" ::: "memory");
  __syncthreads();
  if (threadIdx.x == 0) {
    unsigned* bar = b.bar;
    __builtin_amdgcn_s_waitcnt(0);
    unsigned nloc = b.st[0], nx = b.st[1];
    if (nloc == 0u) { xcd_barrier_complete(bar, b.x, nloc, nx); b.st[0] = nloc; b.st[1] = nx; }
    const unsigned old = xb_add(&bar[XB_XSUB(b.x)], 1u);
    const unsigned gen = old / nloc;
    if (old + 1u == (gen + 1u) * nloc) {
      __builtin_amdgcn_fence(__ATOMIC_RELEASE, "agent");
      asm volatile("s_waitcnt vmcnt(0)" ::: "memory");
      const unsigned og = xb_add(&bar[XB_TOP], 1u);
      const unsigned tg = og / nx;
      if (og + 1u == (tg + 1u) * nx) xb_add(&bar[XB_TOPGEN], 1u);
      else XB_SPIN(xb_ld(&bar[XB_TOPGEN]) == tg, bar);
      __builtin_amdgcn_fence(__ATOMIC_ACQUIRE, "agent");
      xb_add(&bar[XB_XGEN(b.x)], 1u);
      asm volatile("s_waitcnt vmcnt(0)" ::: "memory");
    } else {
      XB_SPIN(xb_ld(&bar[XB_XGEN(b.x)]) == gen, bar);
      __builtin_amdgcn_fence(__ATOMIC_ACQUIRE, "agent");
      asm volatile("s_waitcnt vmcnt(0)" ::: "memory");
    }
  }
  __syncthreads();
}

__global__ void __launch_bounds__(NTHR, 2) fwd_kernel(Params p) {
  const u16* WT = (const u16*)p.ws;
  const u16* XN = (const u16*)(p.ws + OFF_XN);
  const u16* Zc = (const u16*)(p.ws + OFF_Z);
  XcdBarrier xb;
  if (p.coop == 1) {
    volatile LAS unsigned* st = (volatile LAS unsigned*)(smem + LDS_BYTES - 16);
    if (threadIdx.x == 0) { st[0] = 0u; st[1] = 0u; }
    __syncthreads();
    xb = xcd_barrier_post((unsigned*)(p.ws + OFF_BAR), st);
  }
  for (int ph = p.phase_lo; ph < p.phase_hi; ph++) {
    if (ph == 0) continue;
    if (ph == 23) {
      norm_phase<4>(p, 0, p.final_norm_g);
    } else {
      const int l = (ph - 1) / 11, sub = (ph - 1) % 11;
      switch (sub) {
        case 0:
          if (l == 0) { convert_weights(p, 0); norm_phase<0>(p, l, p.norm1_g); }
          else { convert_weights(p, l); norm_phase<1>(p, l, p.norm1_g + (size_t)l * 1024); }
          break;
        case 1: gemm_phase<0>(p, l, XN, 1024, WT + WT_IN, 1024, 4096, 1024); break;
        case 2:
          for (int t = blockIdx.x; t < 2304; t += gridDim.x) {
            int type, idx;
            if (t < 2048) { type = (t >> 9) & 1; idx = (t >> 10) * 512 + (t & 511); }
            else { type = t & 1; idx = 1024 + ((t - 2048) >> 1); }
            const int h = idx & 3, chunk = idx >> 2;
            if (type) c2_delta(p, l, chunk, h); else c2_ret(p, l, chunk, h);
          }
          break;
        case 3: scan_phase(p, l); break;
        case 4: fin_phase(p, l); break;
        case 5: gemm_phase<1>(p, l, XN, 1024, WT + WT_OUT, 1024, 1024, 1024); break;
        case 6: norm_phase<2>(p, l, p.norm2_g + (size_t)l * 1024); break;
        case 7: gemm_phase<2>(p, l, XN, 1024, WT + WT_UP, 1024, 4096, 1024); break;
        case 8: gemm_phase<1>(p, l, Zc, 4096, WT + WT_DOWN, 4096, 1024, 4096); break;
        case 9: norm_phase<3>(p, l, p.ple_norm_g + (size_t)l * 1024); break;
        case 10: gemm_phase<3>(p, l, XN, 1024, WT + WT_GATE, 1024, 1024, 1024); break;
      }
    }
    if (ph + 1 < p.phase_hi) {
      if (p.coop == 1) xcd_barrier(xb);
      else if (p.coop == 2) cg::this_grid().sync();
    }
  }
}

extern "C" void kernel_launch(void* const* d_in, const int* in_sizes, int n_in, void* d_out, int out_size, void* d_ws,
                              size_t ws_size, hipStream_t stream) {
  static int grid_blocks = 0;
  if (!grid_blocks) {
    int dev = 0, cus = 0, per_cu = 0;
    hipGetDevice(&dev);
    hipDeviceGetAttribute(&cus, hipDeviceAttributeMultiprocessorCount, dev);
    hipFuncSetAttribute((const void*)fwd_kernel, hipFuncAttributeMaxDynamicSharedMemorySize, LDS_BYTES);
    hipOccupancyMaxActiveBlocksPerMultiprocessor(&per_cu, fwd_kernel, NTHR, LDS_BYTES);
    if (per_cu < 1) per_cu = 1;
    if (per_cu > 2) per_cu = 2;
    grid_blocks = cus * per_cu;
  }
  Params p{};
  const float** f = (const float**)&p;
  for (int i = 0; i < 23; i++) f[i] = (const float*)d_in[i];
  p.out = (float*)d_out;
  p.ws = (char*)d_ws;
  p.pad = 0;
#ifndef ONE_LAUNCH
  p.coop = 0;
  for (int ph = 0; ph < 24; ph++) {
    p.phase_lo = ph;
    p.phase_hi = ph + 1;
    hipLaunchKernelGGL(fwd_kernel, dim3(grid_blocks), dim3(NTHR), LDS_BYTES, stream, p);
  }
#else
  p.coop = 1;
  hipMemsetAsync((char*)d_ws + OFF_BAR, 0, XCD_BAR_WORDS * 4, stream);
  p.phase_lo = 0;
  p.phase_hi = 24;
  void* args[] = {&p};
  hipError_t e = hipLaunchCooperativeKernel((void*)fwd_kernel, dim3(grid_blocks), dim3(NTHR), args, LDS_BYTES, stream);
  if (e != hipSuccess) fprintf(stderr, "cooperative launch failed: %s (grid %d)\n", hipGetErrorString(e), grid_blocks);
#endif
}
```

```cpp
#include <hip/hip_runtime.h>
#define ONE_LAUNCH 1
#include <hip/hip_bf16.h>
#include <hip/hip_cooperative_groups.h>
#include <cstdio>
namespace cg = cooperative_groups;

typedef unsigned short u16;
using bf16x8 = __attribute__((ext_vector_type(8))) short;
using bf16x4 = __attribute__((ext_vector_type(4))) short;
using f32x4 = __attribute__((ext_vector_type(4))) float;
using f32x16 = __attribute__((ext_vector_type(16))) float;
#define DEVI __device__ __forceinline__

constexpr int NTOK = 18432, NPR = 16384, DM = 1024, ZC = 4096;
constexpr int NTHR = 256;
constexpr int LDS_BYTES = 73728;
constexpr float EPS = 1e-6f;

constexpr size_t WT_IN = 0, WT_OUT = 4194304, WT_UP = 5242880, WT_DOWN = 9437184, WT_PROJ = 13631488,
                 WT_GATE = 13893632, WT_END = 14942208;
constexpr size_t OFF_WSM = WT_END * 2;
constexpr size_t OFF_XN = OFF_WSM + 65536;
constexpr size_t OFF_Z = OFF_XN + 37748736;
constexpr size_t OFF_UTD = OFF_Z + 150994944;
constexpr size_t OFF_ATT = OFF_UTD + 18874368;
constexpr size_t OFF_ZB = OFF_ATT + 18874368;
constexpr size_t OFF_ZS = OFF_ZB + 2654208;
constexpr size_t OFF_GE = OFF_ZS + 589824;
constexpr size_t OFF_BAR = OFF_GE + 8192;
constexpr size_t OFF_TB = OFF_BAR + 16384;
constexpr size_t O_RETP = 18874368, O_DNP = 19136512, O_CONVP = 19398656, O_RETS = 19417088,
                 O_DNS = 23611392, O_CONVS = 27805696;

struct Params {
  const float *x_prompt, *x_sample, *p_prompt, *p_sample, *state_ret, *state_delta, *state_conv;
  const float *norm1_g, *w_in, *conv_w, *dt_bias, *a_log, *ret_norm_g, *dn_norm_g, *w_out, *norm2_g, *w_up,
      *w_down, *ple_proj, *ple_norm_g, *ple_gate_w, *ple_gate_b, *final_norm_g;
  float* out;
  char* ws;
  int phase_lo, phase_hi, coop, pad;
};

extern __shared__ __attribute__((aligned(16))) char smem[];

typedef const __attribute__((address_space(1))) bf16x8* gptr8;
DEVI bf16x8 ldg8(const u16* p) { return *(gptr8)(p); }
DEVI int otid() {
  int t = threadIdx.x;
  asm volatile("" : "+v"(t));
  return t;
}
typedef __bf16 bf2v __attribute__((ext_vector_type(2)));
typedef float f2v __attribute__((ext_vector_type(2)));
typedef unsigned u32x2 __attribute__((ext_vector_type(2)));
DEVI unsigned pk2(float a, float b) {
  f2v v = {a, b};
  bf2v r = __builtin_convertvector(v, bf2v);
  return __builtin_bit_cast(unsigned, r);
}
DEVI u16 f2bf(float f) { return (u16)(pk2(f, 0.f) & 0xffffu); }
DEVI float bf2f(u16 h) { return __uint_as_float(((unsigned)h) << 16); }
DEVI float bfs(short h) { return __uint_as_float(((unsigned)(u16)h) << 16); }
DEVI float wave_sum(float v) {
#pragma unroll
  for (int o = 32; o > 0; o >>= 1) v += __shfl_xor(v, o);
  return v;
}
DEVI float sigmoidf_(float x) { return 1.f / (1.f + __expf(-x)); }
DEVI f32x16 mfma32(bf16x8 a, bf16x8 b, f32x16 c) { return __builtin_amdgcn_mfma_f32_32x32x16_bf16(a, b, c, 0, 0, 0); }
DEVI f32x4 mfma16(bf16x8 a, bf16x8 b, f32x4 c) { return __builtin_amdgcn_mfma_f32_16x16x32_bf16(a, b, c, 0, 0, 0); }
DEVI bf16x4 pack4(float a, float b, float c, float d) {
  u32x2 t = {pk2(a, b), pk2(c, d)};
  return __builtin_bit_cast(bf16x4, t);
}

DEVI void cvt_tile(const float* __restrict__ W, int ldn, int k0, int n0, u16* __restrict__ Wt, int ldk) {
  float* tile = (float*)smem;
  const int tid = otid();
#pragma unroll
  for (int i = 0; i < 4; i++) {
    int kk = (tid >> 4) + 16 * i, n4 = (tid & 15) * 4;
    float4 v = *(const float4*)(W + (size_t)(k0 + kk) * ldn + n0 + n4);
    tile[kk * 65 + n4] = v.x; tile[kk * 65 + n4 + 1] = v.y; tile[kk * 65 + n4 + 2] = v.z; tile[kk * 65 + n4 + 3] = v.w;
  }
  __syncthreads();
  int n = tid >> 2, ks = (tid & 3) * 16;
  bf16x8 o0, o1;
#pragma unroll
  for (int e = 0; e < 8; e++) {
    o0[e] = (short)f2bf(tile[(ks + e) * 65 + n]);
    o1[e] = (short)f2bf(tile[(ks + 8 + e) * 65 + n]);
  }
  u16* dst = Wt + (size_t)(n0 + n) * ldk + k0 + ks;
  *(bf16x8*)dst = o0;
  *(bf16x8*)(dst + 8) = o1;
  __syncthreads();
}

__device__ void convert_weights(const Params& p, int l) {
  u16* WT = (u16*)p.ws;
  const int G = gridDim.x;
  const int tid = otid();
  auto decode = [&](int t, const float*& W, int& ldn, int& k0, int& n0, u16*& D, int& ldk) {
    if (t < 1024) { W = p.w_in + (size_t)l * 1024 * 4104; ldn = 4104; k0 = (t >> 6) * 64; n0 = (t & 63) * 64; D = WT + WT_IN; ldk = 1024; }
    else if (t < 1280) { int u = t - 1024; W = p.w_out + (size_t)l * 1048576; ldn = 1024; k0 = (u >> 4) * 64; n0 = (u & 15) * 64; D = WT + WT_OUT; ldk = 1024; }
    else if (t < 2304) { int u = t - 1280; W = p.w_up + (size_t)l * 4194304; ldn = 4096; k0 = (u >> 6) * 64; n0 = (u & 63) * 64; D = WT + WT_UP; ldk = 1024; }
    else if (t < 3328) { int u = t - 2304; W = p.w_down + (size_t)l * 4194304; ldn = 1024; k0 = (u >> 4) * 64; n0 = (u & 15) * 64; D = WT + WT_DOWN; ldk = 4096; }
    else if (t < 3392) { int u = t - 3328; W = p.ple_proj + (size_t)l * 262144; ldn = 1024; k0 = (u >> 4) * 64; n0 = (u & 15) * 64; D = WT + WT_PROJ; ldk = 256; }
    else { int u = t - 3392; W = p.ple_gate_w + (size_t)l * 1048576; ldn = 1024; k0 = (u >> 4) * 64; n0 = (u & 15) * 64; D = WT + WT_GATE; ldk = 1024; }
  };
  auto load_tile = [&](int t, float4 (&v)[4]) {
    const float* W; int ldn, k0, n0, ldk; u16* D;
    decode(t, W, ldn, k0, n0, D, ldk);
#pragma unroll
    for (int i = 0; i < 4; i++) {
      int kk = (tid >> 4) + 16 * i, n4 = (tid & 15) * 4;
      v[i] = *(const float4*)(W + (size_t)(k0 + kk) * ldn + n0 + n4);
    }
  };
  float* tile = (float*)smem;
  float4 cur[4], nxt[4];
  if ((int)blockIdx.x < 3648) load_tile(blockIdx.x, cur);
  for (int t = blockIdx.x; t < 3648; t += G) {
    const bool has_next = t + G < 3648;
    if (has_next) load_tile(t + G, nxt);
    const float* W; int ldn, k0, n0, ldk; u16* D;
    decode(t, W, ldn, k0, n0, D, ldk);
#pragma unroll
    for (int i = 0; i < 4; i++) {
      int kk = (tid >> 4) + 16 * i, n4 = (tid & 15) * 4;
      tile[kk * 65 + n4] = cur[i].x; tile[kk * 65 + n4 + 1] = cur[i].y; tile[kk * 65 + n4 + 2] = cur[i].z; tile[kk * 65 + n4 + 3] = cur[i].w;
    }
    __syncthreads();
    const int n = tid >> 2, ks = (tid & 3) * 16;
    bf16x8 o0, o1;
#pragma unroll
    for (int e = 0; e < 8; e++) {
      o0[e] = (short)f2bf(tile[(ks + e) * 65 + n]);
      o1[e] = (short)f2bf(tile[(ks + 8 + e) * 65 + n]);
    }
    u16* dst = D + (size_t)(n0 + n) * ldk + k0 + ks;
    *(bf16x8*)dst = o0;
    *(bf16x8*)(dst + 8) = o1;
    __syncthreads();
    if (has_next) {
#pragma unroll
      for (int i = 0; i < 4; i++) cur[i] = nxt[i];
    }
  }
  if (l == 0) {
    float2* TB = (float2*)(p.ws + OFF_TB);
    for (int i = blockIdx.x * NTHR + otid(); i < 4096; i += G * NTHR) {
      float inv = exp2f(-(float)(i & 63) * (13.287712379549449f / 64.f));
      float ang = (float)(i >> 6) * inv;
      TB[i] = make_float2(cosf(ang), sinf(ang));
    }
  }
}

template <int MODE>
__device__ void norm_phase(const Params& p, int l, const float* __restrict__ gain) {
  const int tid = otid();
  const int lane = tid & 63, w = tid >> 6;
  float* H = p.out;
  u16* XN = (u16*)(p.ws + OFF_XN);
  float* ZS = (float*)(p.ws + OFF_ZS);
  const float* wsm = (const float*)(smem + 20480);
  if (MODE == 0 || MODE == 1) {
    float* wl = (float*)(smem + 20480);
    const float* wsrc = p.w_in + (size_t)l * 1024 * 4104 + 4096;
#pragma unroll 4
    for (int it = 0; it < 32; it++) {
      const int idx = it * 256 + tid, k = idx >> 3, j = idx & 7;
      wl[j * 1024 + k] = wsrc[(size_t)k * 4104 + j];
    }
    __syncthreads();
  }
  for (int row = blockIdx.x * 4 + w; row < NTOK; row += gridDim.x * 4) {
    const float* src;
    if (MODE == 0) src = row < NPR ? p.x_prompt + (size_t)row * DM : p.x_sample + (size_t)(row - NPR) * DM;
    else src = H + (size_t)row * DM;
    float4 v[4];
    float ss = 0.f;
#pragma unroll
    for (int i = 0; i < 4; i++) {
      v[i] = *(const float4*)(src + i * 256 + lane * 4);
      ss += v[i].x * v[i].x + v[i].y * v[i].y + v[i].z * v[i].z + v[i].w * v[i].w;
    }
    ss = wave_sum(ss);
    float rstd = rsqrtf(ss * (1.f / 1024.f) + EPS);
    float4 y[4];
#pragma unroll
    for (int i = 0; i < 4; i++) {
      float4 g = *(const float4*)(gain + i * 256 + lane * 4);
      y[i].x = v[i].x * rstd * g.x; y[i].y = v[i].y * rstd * g.y; y[i].z = v[i].z * rstd * g.z; y[i].w = v[i].w * rstd * g.w;
    }
    if (MODE == 4) {
#pragma unroll
      for (int i = 0; i < 4; i++) *(float4*)(H + (size_t)row * DM + i * 256 + lane * 4) = y[i];
    } else {
#pragma unroll
      for (int i = 0; i < 4; i++)
        *(bf16x4*)(XN + (size_t)row * DM + i * 256 + lane * 4) = pack4(y[i].x, y[i].y, y[i].z, y[i].w);
    }
    if (MODE == 0 || MODE == 1) {
      float d[8];
#pragma unroll
      for (int j = 0; j < 8; j++) {
        float a = 0.f;
#pragma unroll
        for (int i = 0; i < 4; i++) {
          float4 wv = *(const float4*)(wsm + j * 1024 + i * 256 + lane * 4);
          a += y[i].x * wv.x + y[i].y * wv.y + y[i].z * wv.z + y[i].w * wv.w;
        }
        d[j] = wave_sum(a);
      }
      if (lane == 0) {
        *(float4*)(ZS + (size_t)row * 8) = make_float4(d[0], d[1], d[2], d[3]);
        *(float4*)(ZS + (size_t)row * 8 + 4) = make_float4(d[4], d[5], d[6], d[7]);
      }
    }
    if (MODE == 3) {
      u16* PB = (u16*)(p.ws + OFF_Z);
      const float* ps = row < NPR ? p.p_prompt + ((size_t)l * NPR + row) * 256
                                  : p.p_sample + ((size_t)l * 2048 + (row - NPR)) * 256;
      float4 pv = *(const float4*)(ps + lane * 4);
      *(bf16x4*)(PB + (size_t)row * 256 + lane * 4) = pack4(pv.x, pv.y, pv.z, pv.w);
    }
  }
}

DEVI int lds_byte(int r, int c) { return r * 128 + ((((c >> 3) ^ (r >> 1)) & 7) << 4) + (c & 7) * 2; }
DEVI void stage_rc(int b, int& R, int& C) {
  R = b >> 7;
  C = ((((b >> 4) ^ (R >> 1)) & 7) << 3);
}

DEVI void gemm_kloop(f32x4 (&acc)[4][4], const u16* __restrict__ A, int lda, const u16* __restrict__ Bt, int ldb,
                     int brow, int bcol, int K, bool pre, const u16* nA, int nlda, const u16* nBt, int nldb, int nbrow,
                     int nbcol) {
  const int tid = otid(), lane = tid & 63, wid = tid >> 6, wr = wid >> 1, wc = wid & 1, fr = lane & 15,
            fq = lane >> 4;
  const int nt = K / 64;
  int sr[4], sc[4];
#pragma unroll
  for (int i = 0; i < 4; i++) stage_rc(tid * 16 + i * 4096, sr[i], sc[i]);
  const u16* Ab = A + (size_t)brow * lda;
  const u16* Bb = Bt + (size_t)bcol * ldb;
#define GSTAGE(buf, kt)                                                                                         \
  do {                                                                                                          \
    _Pragma("unroll") for (int i = 0; i < 4; i++) {                                                             \
      int b_ = tid * 16 + i * 4096;                                                                             \
      __builtin_amdgcn_global_load_lds((const unsigned*)(Ab + (size_t)sr[i] * lda + (kt) * 64 + sc[i]),         \
                                       (unsigned*)(smem + (buf) * 32768 + b_), 16, 0, 0);                       \
      __builtin_amdgcn_global_load_lds((const unsigned*)(Bb + (size_t)sr[i] * ldb + (kt) * 64 + sc[i]),         \
                                       (unsigned*)(smem + (buf) * 32768 + 16384 + b_), 16, 0, 0);               \
    }                                                                                                           \
  } while (0)
#define GSTAGE_NEXT(buf, kt)                                                                                    \
  do {                                                                                                          \
    const u16* nAb_ = nA + (size_t)nbrow * nlda;                                                                \
    const u16* nBb_ = nBt + (size_t)nbcol * nldb;                                                               \
    _Pragma("unroll") for (int i = 0; i < 4; i++) {                                                             \
      int b_ = tid * 16 + i * 4096;                                                                             \
      __builtin_amdgcn_global_load_lds((const unsigned*)(nAb_ + (size_t)sr[i] * nlda + (kt) * 64 + sc[i]),      \
                                       (unsigned*)(smem + (buf) * 32768 + b_), 16, 0, 0);                       \
      __builtin_amdgcn_global_load_lds((const unsigned*)(nBb_ + (size_t)sr[i] * nldb + (kt) * 64 + sc[i]),      \
                                       (unsigned*)(smem + (buf) * 32768 + 16384 + b_), 16, 0, 0);               \
    }                                                                                                           \
  } while (0)
  if (!pre) { GSTAGE(0, 0); GSTAGE(1, 1); }
  for (int t = 0; t < nt; t++) {
    if (t > 0 && (t + 1 < nt || nA)) asm volatile("s_waitcnt vmcnt(8)" ::: "memory");
    else asm volatile("s_waitcnt vmcnt(0)" ::: "memory");
    __builtin_amdgcn_s_barrier();
    asm volatile("" ::: "memory");
    const char* sa = smem + (t & 1) * 32768;
    const char* sb = sa + 16384;
    bf16x8 af[4][2], bf[4][2];
#pragma unroll
    for (int m = 0; m < 4; m++)
#pragma unroll
      for (int k = 0; k < 2; k++) af[m][k] = *(const bf16x8*)(sa + lds_byte(wr * 64 + m * 16 + fr, k * 32 + fq * 8));
#pragma unroll
    for (int n = 0; n < 4; n++)
#pragma unroll
      for (int k = 0; k < 2; k++) bf[n][k] = *(const bf16x8*)(sb + lds_byte(wc * 64 + n * 16 + fr, k * 32 + fq * 8));
    asm volatile("s_waitcnt lgkmcnt(0)" ::: "memory");
    __builtin_amdgcn_s_barrier();
    asm volatile("" ::: "memory");
    if (t + 2 < nt) GSTAGE(t & 1, t + 2);
    else if (nA) GSTAGE_NEXT(t & 1, t + 2 - nt);
#pragma unroll
    for (int k = 0; k < 2; k++)
#pragma unroll
      for (int m = 0; m < 4; m++)
#pragma unroll
        for (int n = 0; n < 4; n++) acc[m][n] = mfma16(bf[n][k], af[m][k], acc[m][n]);
  }
#undef GSTAGE_NEXT
#undef GSTAGE
}

template <int EPI>
__device__ void gemm_phase(const Params& p, int l, const u16* A, int lda, const u16* Bt, int ldb, int N, int K) {
  const int tid = otid(), lane = tid & 63, wid = tid >> 6, wr = wid >> 1, wc = wid & 1, fr = lane & 15,
            fq = lane >> 4;
  const int nN = N / 128, ntile = (NTOK / 128) * nN;
  u16* Z = (u16*)(p.ws + OFF_Z);
  float* H = p.out;
  auto tile_of = [&](int t, int& tm, int& tn) -> bool {
    if (t >= ntile) return false;
    tn = t % nN; tm = t / nN;
    if (gridDim.x == 512) {
      const int k = t >> 9, x = blockIdx.x & 7, j = blockIdx.x >> 3;
      const int nsb = 18 * (nN >> 3), sb = k * 8 + x;
      if (k * 8 + 8 <= nsb) {
        const int tnb = sb % (nN >> 3), tmb = sb / (nN >> 3);
        tm = tmb * 8 + (j >> 3);
        tn = tnb * 8 + (j & 7);
      } else {
        if (j >= 16) return false;
        tm = 128 + x * 2 + (j >> 3);
        tn = j & 7;
      }
    }
    return true;
  };
  const u16* PBp = (const u16*)(p.ws + OFF_Z);
  const u16* WPp = (const u16*)p.ws + WT_PROJ;
  bool pre = false;
  for (int t = blockIdx.x; t < ntile; t += gridDim.x) {
    int tm, tn, ntm = 0, ntn = 0;
    if (!tile_of(t, tm, tn)) break;
    const bool has_next = tile_of(t + gridDim.x, ntm, ntn);
    const int brow = tm * 128, bcol = tn * 128;
    f32x4 acc[4][4];
#pragma unroll
    for (int m = 0; m < 4; m++)
#pragma unroll
      for (int n = 0; n < 4; n++) acc[m][n] = f32x4{0.f, 0.f, 0.f, 0.f};
    if (EPI != 3) {
      gemm_kloop(acc, A, lda, Bt, ldb, brow, bcol, K, pre, has_next ? A : nullptr, lda, Bt, ldb, ntm * 128, ntn * 128);
      pre = has_next;
    }
    if (EPI == 3) {
      u16* PP = (u16*)(p.ws + OFF_UTD);
      gemm_kloop(acc, PBp, 256, WPp, 256, brow, bcol, 256, pre, A, lda, Bt, ldb, brow, bcol);
#pragma unroll
      for (int m = 0; m < 4; m++)
#pragma unroll
        for (int n = 0; n < 4; n++) {
          int row = brow + wr * 64 + m * 16 + fr, col = bcol + wc * 64 + n * 16 + fq * 4;
          *(bf16x4*)(PP + (size_t)row * DM + col) = pack4(acc[m][n][0], acc[m][n][1], acc[m][n][2], acc[m][n][3]);
          acc[m][n] = f32x4{0.f, 0.f, 0.f, 0.f};
        }
      gemm_kloop(acc, A, lda, Bt, ldb, brow, bcol, K, true, has_next ? PBp : nullptr, 256, WPp, 256, ntm * 128, ntn * 128);
      pre = has_next;
#pragma unroll
      for (int m = 0; m < 4; m++)
#pragma unroll
        for (int n = 0; n < 4; n++) {
          int row = brow + wr * 64 + m * 16 + fr, col = bcol + wc * 64 + n * 16 + fq * 4;
          float4 b = *(const float4*)(p.ple_gate_b + (size_t)l * 1024 + col);
          float4* hp = (float4*)(H + (size_t)row * DM + col);
          float4 hv = *hp;
          const bf16x4 pq = *(const bf16x4*)(PP + (size_t)row * DM + col);
          hv.x += bfs(pq[0]) * sigmoidf_(acc[m][n][0] + b.x);
          hv.y += bfs(pq[1]) * sigmoidf_(acc[m][n][1] + b.y);
          hv.z += bfs(pq[2]) * sigmoidf_(acc[m][n][2] + b.z);
          hv.w += bfs(pq[3]) * sigmoidf_(acc[m][n][3] + b.w);
          *hp = hv;
        }
    } else {
#pragma unroll
      for (int m = 0; m < 4; m++)
#pragma unroll
        for (int n = 0; n < 4; n++) {
          int row = brow + wr * 64 + m * 16 + fr, col = bcol + wc * 64 + n * 16 + fq * 4;
          f32x4 a = acc[m][n];
          if (EPI == 0) {
            bf16x4 zb4 = pack4(a[0], a[1], a[2], a[3]);
            *(bf16x4*)(Z + (size_t)row * ZC + col) = zb4;
            int rr = (row & 63) - 61;
            if (rr >= 0 && col >= 2048 && col < 3584) {
              u16* ZB = (u16*)(p.ws + OFF_ZB);
              int ch = col - 2048;
              *(bf16x4*)(ZB + ((size_t)(row >> 6) * 3 + rr) * 1536 + ch) = zb4;
              if (row >= NPR) {
                int b = (row - NPR) >> 6;
                *(float4*)(p.out + O_CONVS + (((size_t)l * 32 + b) * 3 + rr) * 1536 + ch) = make_float4(a[0], a[1], a[2], a[3]);
              } else if ((row & 8191) >= 8189) {
                int b = row >> 13;
                *(float4*)(p.out + O_CONVP + (((size_t)l * 2 + b) * 3 + rr) * 1536 + ch) = make_float4(a[0], a[1], a[2], a[3]);
              }
            }
          } else if (EPI == 1) {
            float4* hp = (float4*)(H + (size_t)row * DM + col);
            const float* rs = (l == 0 && K == 1024)
                                  ? (row < NPR ? p.x_prompt + (size_t)row * DM + col : p.x_sample + (size_t)(row - NPR) * DM + col)
                                  : (const float*)hp;
            float4 hv = *(const float4*)rs;
            hv.x += a[0]; hv.y += a[1]; hv.z += a[2]; hv.w += a[3];
            *hp = hv;
          } else if (EPI == 2) {
            float r0 = fmaxf(a[0], 0.f), r1 = fmaxf(a[1], 0.f), r2 = fmaxf(a[2], 0.f), r3 = fmaxf(a[3], 0.f);
            *(bf16x4*)(Z + (size_t)row * ZC + col) = pack4(r0 * r0, r1 * r1, r2 * r2, r3 * r3);
          }
        }
    }
  }
}


template <int KS>
DEVI int fragA(int row, int k8) { return ((((row >> 5) * KS + (k8 >> 1)) * 2 + (k8 & 1)) * 32 + (row & 31)) * 8; }
DEVI int fragU(int dv, int tok) {
  return ((((dv >> 5) * 2 + (tok >> 5)) * 64 + ((tok >> 2) & 1) * 32 + (dv & 31)) * 16) + ((tok >> 3) & 3) * 4;
}
DEVI size_t slotaddr(int row0, int slot, int L) { return (size_t)(row0 + (L >> 7)) * ZC + slot + (L & 127); }

constexpr int LP = 136;

__device__ void c2_ret(const Params& p, int l, int chunk, int h) {
  u16* Z = (u16*)(p.ws + OFF_Z);
  u16* ATT = (u16*)(p.ws + OFF_ATT);
  int tid_ = threadIdx.x;
  asm volatile("" : "+v"(tid_));
  const int tid = tid_, lane = tid & 63, w = __builtin_amdgcn_readfirstlane(tid >> 6), r = lane & 31, hh = lane >> 5;
  u16* qs = (u16*)smem;
  u16* ks = qs + 64 * LP;
  u16* vs = ks + 64 * LP;
  const int row0 = chunk * 64;
  const bool is_sample = chunk >= 256;
  const int pos0 = is_sample ? 4096 : (chunk & 127) * 64;
  const float lg2 = log2f(1.f - exp2f(-5.f - (float)h));
  const int cq = h * 128, ck = 512 + h * 128, cv = 1024 + h * 128;
  {
    const float2* TB = (const float2*)(p.ws + OFF_TB);
    float2* ab = (float2*)(smem + 52224);
    bf16x8 q1[2], q2[2], k1[2], k2[2], vv[4];
#pragma unroll
    for (int it = 0; it < 2; it++) {
      int item = it * 256 + tid;
      int t = item >> 3, cg8 = (item & 7) * 8;
      size_t zr = (size_t)(row0 + t) * ZC;
      q1[it] = *(const bf16x8*)(Z + zr + cq + cg8); q2[it] = *(const bf16x8*)(Z + zr + cq + 64 + cg8);
      k1[it] = *(const bf16x8*)(Z + zr + ck + cg8); k2[it] = *(const bf16x8*)(Z + zr + ck + 64 + cg8);
    }
#pragma unroll
    for (int it = 0; it < 4; it++) {
      int item = it * 256 + tid;
      vv[it] = *(const bf16x8*)(Z + (size_t)(row0 + (item >> 4)) * ZC + cv + (item & 15) * 8);
    }
    if (tid < 64) {
      float inv = exp2f(-(float)tid * (13.287712379549449f / 64.f));
      float ang = (float)pos0 * inv;
      ab[tid] = make_float2(cosf(ang), sinf(ang));
    }
#pragma unroll
    for (int it = 0; it < 4; it++) {
      int item = it * 256 + tid;
      *(bf16x8*)(vs + (item >> 4) * LP + (item & 15) * 8) = vv[it];
    }
    __syncthreads();
#pragma unroll
    for (int it = 0; it < 2; it++) {
      int item = it * 256 + tid;
      int t = item >> 3, cg8 = (item & 7) * 8;
      bf16x8 sq1, sq2, sk1, sk2;
#pragma unroll
      for (int e = 0; e < 8; e++) {
        int d = cg8 + e;
        float2 B = TB[t * 64 + d], A = ab[d];
        float cs = A.x * B.x - A.y * B.y, sn = A.y * B.x + A.x * B.y;
        float a = bfs(q1[it][e]), b = bfs(q2[it][e]);
        float qa = a * cs - b * sn, qb = a * sn + b * cs;
        sq1[e] = (short)f2bf(qa); sq2[e] = (short)f2bf(qb);
        a = bfs(k1[it][e]); b = bfs(k2[it][e]);
        float ka = (a * cs - b * sn) * 0.08838834764831845f, kb = (a * sn + b * cs) * 0.08838834764831845f;
        sk1[e] = (short)f2bf(ka); sk2[e] = (short)f2bf(kb);
      }
      *(bf16x8*)(qs + t * LP + cg8) = sq1; *(bf16x8*)(qs + t * LP + 64 + cg8) = sq2;
      *(bf16x8*)(ks + t * LP + cg8) = sk1; *(bf16x8*)(ks + t * LP + 64 + cg8) = sk2;
    }
  }
  __syncthreads();
  {
    const int ib = w & 1, jb = w >> 1;
    f32x16 acc;
#pragma unroll
    for (int e = 0; e < 16; e++) acc[e] = 0.f;
#pragma unroll
    for (int kk = 0; kk < 8; kk++) {
      bf16x8 a = *(const bf16x8*)(ks + (jb * 32 + r) * LP + kk * 16 + hh * 8);
      bf16x8 b = *(const bf16x8*)(qs + (ib * 32 + r) * LP + kk * 16 + hh * 8);
      acc = mfma32(a, b, acc);
    }
    const int i = ib * 32 + r;
    u16* att = ATT + (size_t)(chunk * 4 + h) * 4096;
#pragma unroll
    for (int g = 0; g < 4; g++) {
      int j0 = jb * 32 + 8 * g + 4 * hh;
      float o[4];
#pragma unroll
      for (int e = 0; e < 4; e++) {
        int dj = i - (j0 + e);
        dj = dj < 0 ? -dj : dj;
        o[e] = acc[4 * g + e] * exp2f(lg2 * (float)dj);
      }
      *(bf16x4*)(att + fragA<4>(i, j0 >> 3) + (j0 & 7)) = pack4(o[0], o[1], o[2], o[3]);
    }
  }
#pragma unroll 1
  for (int it = 0; it < 4; it++) {
    int item = it * 256 + tid;
    int t = item >> 4, c16 = item & 15;
    bf16x8 v = *(const bf16x8*)(qs + t * LP + c16 * 8);
    float cross = exp2f(lg2 * (float)(t + 1));
    bf16x8 o;
#pragma unroll
    for (int e = 0; e < 8; e++) o[e] = (short)f2bf(bfs(v[e]) * cross);
    *(bf16x8*)(Z + slotaddr(row0, cq, fragA<8>(t, c16))) = o;
  }
  {
    const int d = tid & 127, half = tid >> 7;
#pragma unroll
    for (int q4 = 0; q4 < 4; q4++) {
      bf16x8 ok;
      bf16x4 ov0, ov1;
      const int t8 = half * 32 + q4 * 8;
#pragma unroll
      for (int e = 0; e < 8; e++) {
        int tt = t8 + e;
        ok[e] = (short)f2bf(bf2f(ks[tt * LP + d]) * exp2f(lg2 * (float)(63 - tt)));
        if (e < 4) ov0[e & 3] = (short)vs[tt * LP + d]; else ov1[e & 3] = (short)vs[tt * LP + d];
      }
      *(bf16x8*)(Z + slotaddr(row0, ck, fragA<4>(d, t8 >> 3))) = ok;
      *(bf16x4*)(Z + slotaddr(row0, cv, fragU(d, t8))) = ov0;
      *(bf16x4*)(Z + slotaddr(row0, cv, fragU(d, t8 + 4))) = ov1;
    }
  }
  __syncthreads();
}

__device__ void c2_delta(const Params& p, int l, int chunk, int h) {
  u16* Z = (u16*)(p.ws + OFF_Z);
  u16* ATT = (u16*)(p.ws + OFF_ATT);
  u16* UTD = (u16*)(p.ws + OFF_UTD);
  const u16* ZB = (const u16*)(p.ws + OFF_ZB);
  const float* ZS = (const float*)(p.ws + OFF_ZS);
  float* GE = (float*)(p.ws + OFF_GE);
  int tid_ = threadIdx.x;
  asm volatile("" : "+v"(tid_));
  const int tid = tid_, lane = tid & 63, w = __builtin_amdgcn_readfirstlane(tid >> 6), r = lane & 31, hh = lane >> 5;
  u16* qs = (u16*)smem;
  u16* ks = qs + 64 * LP;
  u16* vs = ks + 64 * LP;
  float* Af = (float*)(vs + 64 * LP);
  float* gcs = Af + 4096;
  float* su = gcs + 64;
  float* sw = su + 64;
  float* egq = sw + 64;
  float* egk = egq + 64;
  const int row0 = chunk * 64;
  const bool is_sample = chunk >= 256;
  const int nseq = is_sample ? 0 : (chunk & 127);
  const int sb = chunk - 256;
  if (w < 3) {
    const int part = w, tb = lane >> 4, cg8 = (lane & 15) * 8;
    const int ch = part * 512 + h * 128 + cg8;
    bf16x8 xr[19];
#pragma unroll
    for (int j = 0; j < 19; j++) {
      int tt = tb * 16 - 3 + j;
      tt = tt < 0 ? 0 : tt;
      xr[j] = *(const bf16x8*)(Z + (size_t)(row0 + tt) * ZC + 2048 + ch);
    }
    float4 cw0[4], cw1[4];
#pragma unroll
    for (int i = 0; i < 4; i++) {
      const float* cw = p.conv_w + ((size_t)l * 4 + i) * 1536 + ch;
      cw0[i] = *(const float4*)cw;
      cw1[i] = *(const float4*)(cw + 4);
    }
    if (tb == 0) {
#pragma unroll
      for (int j = 0; j < 3; j++) {
        if (is_sample) {
          const float* s = p.state_conv + (((size_t)l * 32 + sb) * 3 + j) * 1536 + ch;
          float4 s0 = *(const float4*)s, s1 = *(const float4*)(s + 4);
          u32x2 lo = {pk2(s0.x, s0.y), pk2(s0.z, s0.w)}, hi = {pk2(s1.x, s1.y), pk2(s1.z, s1.w)};
          bf16x4 l4 = __builtin_bit_cast(bf16x4, lo), h4 = __builtin_bit_cast(bf16x4, hi);
          xr[j] = bf16x8{l4[0], l4[1], l4[2], l4[3], h4[0], h4[1], h4[2], h4[3]};
        } else if (nseq > 0) {
          xr[j] = *(const bf16x8*)(ZB + ((size_t)(chunk - 1) * 3 + j) * 1536 + ch);
        } else {
          xr[j] = bf16x8{0, 0, 0, 0, 0, 0, 0, 0};
        }
      }
    }
    u16* dst = part == 0 ? qs : (part == 1 ? ks : vs);
#pragma unroll
    for (int i = 0; i < 16; i++) {
      float a[8];
#pragma unroll
      for (int e = 0; e < 8; e++) a[e] = 0.f;
#pragma unroll
      for (int tp = 0; tp < 4; tp++) {
        const bf16x8 v = xr[i + tp];
        a[0] += bfs(v[0]) * cw0[tp].x; a[1] += bfs(v[1]) * cw0[tp].y; a[2] += bfs(v[2]) * cw0[tp].z; a[3] += bfs(v[3]) * cw0[tp].w;
        a[4] += bfs(v[4]) * cw1[tp].x; a[5] += bfs(v[5]) * cw1[tp].y; a[6] += bfs(v[6]) * cw1[tp].z; a[7] += bfs(v[7]) * cw1[tp].w;
      }
      float ss = 0.f;
#pragma unroll
      for (int e = 0; e < 8; e++) {
        a[e] = a[e] * sigmoidf_(a[e]);
        ss += a[e] * a[e];
      }
      if (part < 2) {
        ss += __shfl_xor(ss, 1); ss += __shfl_xor(ss, 2); ss += __shfl_xor(ss, 4); ss += __shfl_xor(ss, 8);
        float sc = rsqrtf(ss + EPS) * (part == 0 ? 0.08838834764831845f : 1.f);
#pragma unroll
        for (int e = 0; e < 8; e++) a[e] *= sc;
      }
      u32x2 lo = {pk2(a[0], a[1]), pk2(a[2], a[3])}, hi = {pk2(a[4], a[5]), pk2(a[6], a[7])};
      *(u32x2*)(dst + (tb * 16 + i) * LP + cg8) = lo;
      *(u32x2*)(dst + (tb * 16 + i) * LP + cg8 + 4) = hi;
    }
  }
  if (w == 3) {
    const int row = row0 + lane;
    float bb = ZS[(size_t)row * 8 + h], ab = ZS[(size_t)row * 8 + 4 + h];
    float beta = sigmoidf_(bb);
    float x = ab + p.dt_bias[l * 4 + h];
    float sp = x > 20.f ? x : log1pf(expf(x));
    float gc = -expf(p.a_log[l * 4 + h]) * sp;
#pragma unroll
    for (int o = 1; o < 64; o <<= 1) {
      float v = __shfl_up(gc, o);
      if (lane >= o) gc += v;
    }
    float gl = __shfl(gc, 63);
    gcs[lane] = gc;
    su[lane] = beta;
    sw[lane] = beta * expf(gc);
    egq[lane] = expf(gc);
    egk[lane] = expf(gl - gc);
    if (lane == 63) GE[chunk * 4 + h] = expf(gc);
  }
  __syncthreads();
  {
    const int ib = w & 1, jb = w >> 1;
    const int i = ib * 32 + r;
    u16* att = ATT + (size_t)(1152 + chunk * 4 + h) * 4096;
    if (jb <= ib) {
      f32x16 aK, aQ;
#pragma unroll
      for (int e = 0; e < 16; e++) { aK[e] = 0.f; aQ[e] = 0.f; }
#pragma unroll
      for (int kk = 0; kk < 8; kk++) {
        bf16x8 a = *(const bf16x8*)(ks + (jb * 32 + r) * LP + kk * 16 + hh * 8);
        bf16x8 bk = *(const bf16x8*)(ks + (ib * 32 + r) * LP + kk * 16 + hh * 8);
        bf16x8 bq = *(const bf16x8*)(qs + (ib * 32 + r) * LP + kk * 16 + hh * 8);
        aK = mfma32(a, bk, aK);
        aQ = mfma32(a, bq, aQ);
      }
      const float gi = gcs[i], bi = su[i];
#pragma unroll
      for (int g = 0; g < 4; g++) {
        int j0 = jb * 32 + 8 * g + 4 * hh;
        float oa[4], oq[4];
#pragma unroll
        for (int e = 0; e < 4; e++) {
          int j = j0 + e;
          float dec = (i >= j) ? expf(gi - gcs[j]) : 0.f;
          oa[e] = (i > j) ? aK[4 * g + e] * bi * dec : 0.f;
          oq[e] = aQ[4 * g + e] * dec;
        }
        *(float4*)(Af + i * 64 + j0) = make_float4(oa[0], oa[1], oa[2], oa[3]);
        *(bf16x4*)(att + fragA<4>(i, j0 >> 3) + (j0 & 7)) = pack4(oq[0], oq[1], oq[2], oq[3]);
      }
    } else {
#pragma unroll
      for (int g = 0; g < 4; g++) {
        int j0 = jb * 32 + 8 * g + 4 * hh;
        *(float4*)(Af + i * 64 + j0) = make_float4(0.f, 0.f, 0.f, 0.f);
        *(bf16x4*)(att + fragA<4>(i, j0 >> 3) + (j0 & 7)) = bf16x4{0, 0, 0, 0};
      }
    }
  }
  __syncthreads();
  {
#pragma unroll 1
    for (int it = 0; it < 4; it++) {
      int item = it * 256 + tid;
      int t = item >> 4, c8 = (item & 15) * 8;
      bf16x8 v = *(const bf16x8*)(qs + t * LP + c8);
      float sc = egq[t];
      bf16x8 o;
#pragma unroll
      for (int e = 0; e < 8; e++) o[e] = (short)f2bf(bfs(v[e]) * sc);
      *(bf16x8*)(Z + slotaddr(row0, 2560 + h * 128, fragA<8>(t, c8 >> 3))) = o;
    }
    const int d = tid & 127, half = tid >> 7;
#pragma unroll
    for (int q4 = 0; q4 < 4; q4++) {
      bf16x8 ok;
#pragma unroll
      for (int e = 0; e < 8; e++) {
        int tt = half * 32 + q4 * 8 + e;
        ok[e] = (short)f2bf(bf2f(ks[tt * LP + d]) * egk[tt]);
      }
      *(bf16x8*)(Z + slotaddr(row0, 3072 + h * 128, fragA<4>(d, (half * 32 + q4 * 8) >> 3))) = ok;
    }
  }
  __syncthreads();
  {
    const int cc = tid & 127;
    const u16* src = (tid < 128) ? vs : ks;
    const float* scl = (tid < 128) ? su : sw;
    float x[64];
    int vzero;
    asm volatile("v_mov_b32 %0, 0" : "=v"(vzero));
    const float* Afv = Af + vzero;
    const float* sclv = scl + vzero;
#pragma unroll
    for (int i = 0; i < 64; i++) {
      float acc = bf2f(src[i * LP + cc]) * sclv[i], acc2 = 0.f;
#pragma unroll
      for (int j4 = 0; j4 < (i + 3) / 4; j4++) {
        float4 av = *(const float4*)(Afv + i * 64 + j4 * 4);
        if (j4 * 4 + 0 < i) acc -= av.x * x[j4 * 4 + 0];
        if (j4 * 4 + 1 < i) acc2 -= av.y * x[j4 * 4 + 1];
        if (j4 * 4 + 2 < i) acc -= av.z * x[j4 * 4 + 2];
        if (j4 * 4 + 3 < i) acc2 -= av.w * x[j4 * 4 + 3];
      }
      x[i] = acc + acc2;
      __builtin_amdgcn_sched_barrier(0);
    }
    if (tid < 128) {
      u16* ut = UTD + (size_t)(chunk * 4 + h) * 8192;
#pragma unroll
      for (int q4 = 0; q4 < 16; q4++)
        *(bf16x4*)(ut + fragU(cc, q4 * 4)) = pack4(x[q4 * 4], x[q4 * 4 + 1], x[q4 * 4 + 2], x[q4 * 4 + 3]);
    } else {
#pragma unroll
      for (int i = 0; i < 64; i++) qs[i * LP + cc] = f2bf(x[i]);
    }
  }
  __syncthreads();
#pragma unroll 1
  for (int it = 0; it < 4; it++) {
    int item = it * 256 + tid;
    int t = item >> 4, c8 = (item & 15) * 8;
    *(bf16x8*)(Z + slotaddr(row0, 2048 + h * 128, fragA<8>(t, c8 >> 3))) = *(const bf16x8*)(qs + t * LP + c8);
  }
  __syncthreads();
}

constexpr int STP = 136, VNP = 72, OBP = 40;
__device__ void scan_task(const Params& p, int l, int type, int seq, int h, int s) {
  const u16* Z = (const u16*)(p.ws + OFF_Z);
  const u16* ATT = (const u16*)(p.ws + OFF_ATT);
  const u16* UTD = (const u16*)(p.ws + OFF_UTD);
  const float* GE = (const float*)(p.ws + OFF_GE);
  u16* XN = (u16*)(p.ws + OFF_XN);
  const int tid = otid(), lane = tid & 63, w = __builtin_amdgcn_readfirstlane(tid >> 6), r = lane & 31, hh = lane >> 5;
  u16* ST = (u16*)smem;
  u16* VNT = ST + 32 * STP;
  u16* OB = VNT + 32 * VNP;
  const int nchunks = seq < 2 ? 128 : 1;
  const int chunk0 = seq < 2 ? seq * 128 : 256 + (seq - 2);
  const int dv0 = s * 32;
  const int c0 = type ? 2048 + h * 128 : h * 128;
  const int c1 = c0 + 512, c2 = c0 + 1024;
  const int colA8 = (w < 2) ? c0 : (type ? c1 : c0);
  const int colKT = type ? c2 : c1;
  const int mb = w & 1;
  const float carry = exp2f(64.f * log2f(1.f - exp2f(-5.f - (float)h)));
  f32x16 S;
  if (seq < 2) {
#pragma unroll
    for (int e = 0; e < 16; e++) S[e] = 0.f;
  } else {
    const float* s0 = (type ? p.state_delta : p.state_ret) + (((size_t)l * 32 + (seq - 2)) * 4 + h) * 16384;
#pragma unroll
    for (int e = 0; e < 16; e++) {
      int dk = w * 32 + (e & 3) + 8 * (e >> 2) + 4 * hh;
      S[e] = s0[(size_t)dk * 128 + dv0 + r];
    }
  }
#pragma unroll
  for (int g = 0; g < 4; g++)
    *(bf16x4*)(ST + r * STP + w * 32 + 8 * g + 4 * hh) = pack4(S[4 * g], S[4 * g + 1], S[4 * g + 2], S[4 * g + 3]);

  struct Ops { bf16x8 F8[8]; bf16x8 F4[4]; bf16x8 KT[4]; };
  const bool needA8 = (w >= 2) || type;
  auto load_ops = [&](Ops& o, int chunk) {
    const u16* zb = Z + (size_t)(chunk * 64 + (lane >> 4)) * ZC + (lane & 15) * 8;
    asm volatile("" : "+v"(zb));
    {
      const u16* a8 = zb + (size_t)(mb * 32) * ZC + colA8;
#pragma unroll
      for (int ks = 0; ks < 8; ks++) o.F8[ks] = ldg8(a8 + (size_t)(ks * 4) * ZC);
    }
    {
      const u16* f4p;
      int f4s;
      if (w >= 2) {
        f4p = ATT + (size_t)(type * 1152 + chunk * 4 + h) * 4096 + (mb * 256 + lane) * 8;
        f4s = 512;
      } else {
        const int L_ = ((s * 2 + mb) * 64 + lane) * 16;
        f4p = type ? UTD + (size_t)(chunk * 4 + h) * 8192 + L_ : Z + slotaddr(chunk * 64, c2, L_);
        f4s = 8;
      }
#pragma unroll
      for (int ks = 0; ks < 4; ks++) o.F4[ks] = ldg8(f4p + ((w >= 2) ? ks : (ks & 1)) * f4s);
    }
    {
      const u16* kt = zb + (size_t)(w * 16) * ZC + colKT;
#pragma unroll
      for (int ks = 0; ks < 4; ks++) o.KT[ks] = ldg8(kt + (size_t)(ks * 4) * ZC);
    }
  };
#define LBAR() do { asm volatile("s_waitcnt lgkmcnt(0)" ::: "memory"); __builtin_amdgcn_s_barrier(); asm volatile("" ::: "memory"); } while (0)
  auto step = [&](const Ops& o, int chunk, float ge) {
    f32x16 acc;
#pragma unroll
    for (int e = 0; e < 16; e++) acc[e] = 0.f;
    if (needA8) {
      f32x16 acc2;
#pragma unroll
      for (int e = 0; e < 16; e++) acc2[e] = 0.f;
      bf16x8 sb[8];
#pragma unroll
      for (int ks = 0; ks < 8; ks++) sb[ks] = *(const bf16x8*)(ST + r * STP + ks * 16 + hh * 8);
#pragma unroll
      for (int ks = 0; ks < 8; ks += 2) {
        acc = mfma32(o.F8[ks], sb[ks], acc);
        acc2 = mfma32(o.F8[ks + 1], sb[ks + 1], acc2);
      }
#pragma unroll
      for (int e = 0; e < 16; e++) acc[e] += acc2[e];
    }
    if (w < 2) {
#pragma unroll
      for (int g = 0; g < 4; g++) {
        const bf16x8 uu = o.F4[g >> 1];
        const int ub = (g & 1) * 4;
        float v0 = bfs(uu[ub]) - acc[4 * g], v1 = bfs(uu[ub + 1]) - acc[4 * g + 1], v2 = bfs(uu[ub + 2]) - acc[4 * g + 2],
              v3 = bfs(uu[ub + 3]) - acc[4 * g + 3];
        *(bf16x4*)(VNT + r * VNP + mb * 32 + 8 * g + 4 * hh) = pack4(v0, v1, v2, v3);
      }
    }
    LBAR();
    bf16x8 vb[4];
#pragma unroll
    for (int ks = 0; ks < 4; ks++) vb[ks] = *(const bf16x8*)(VNT + r * VNP + ks * 16 + hh * 8);
#pragma unroll
    for (int e = 0; e < 16; e++) S[e] *= ge;
#pragma unroll
    for (int ks = 0; ks < 4; ks++) S = mfma32(o.KT[ks], vb[ks], S);
#pragma unroll
    for (int g = 0; g < 4; g++)
      *(bf16x4*)(ST + r * STP + w * 32 + 8 * g + 4 * hh) = pack4(S[4 * g], S[4 * g + 1], S[4 * g + 2], S[4 * g + 3]);
    if (w >= 2) {
#pragma unroll
      for (int ks = 0; ks < 4; ks++) acc = mfma32(o.F4[ks], vb[ks], acc);
      u16* op = XN + (size_t)(chunk * 64 + mb * 32) * DM + type * 512 + h * 128 + dv0 + r;
#pragma unroll
      for (int e = 0; e < 16; e++) {
        const int tok = (e & 3) + 8 * (e >> 2) + 4 * hh;
        const unsigned val = f2bf(acc[e]);
        asm volatile("global_store_short %0, %1, off" ::"v"(op + (size_t)tok * DM), "v"(val) : "memory");
      }
    }
    LBAR();
  };
  float gev0 = carry, gev1 = carry;
  if (type) {
    gev0 = (lane < nchunks) ? GE[(chunk0 + lane) * 4 + h] : 1.f;
    gev1 = (64 + lane < nchunks) ? GE[(chunk0 + 64 + lane) * 4 + h] : 1.f;
  }
  auto flush = [&](int cbase, int nst) {
    for (int it = tid; it < nst * 256; it += 256) {
      int st = it >> 8, tok = (it >> 2) & 63, pc = it & 3;
      bf16x8 v = *(const bf16x8*)(OB + (((cbase + st) & 7) * 64 + tok) * OBP + pc * 8);
      *(bf16x8*)(XN + (size_t)((cbase + st) * 64 + tok) * DM + type * 512 + h * 128 + dv0 + pc * 8) = v;
    }
    __builtin_amdgcn_s_waitcnt(0x0F70);
  };
  Ops A, B;
  load_ops(A, chunk0);
  __syncthreads();
#define GEV(n_) __uint_as_float(__builtin_amdgcn_readlane(__float_as_uint((n_) < 64 ? gev0 : gev1), (n_) & 63))
  int n = 0;
#pragma unroll 1
  for (; n + 2 < nchunks; n += 2) {
    load_ops(B, chunk0 + n + 1);
    step(A, chunk0 + n, GEV(n));
    load_ops(A, chunk0 + n + 2);
    step(B, chunk0 + n + 1, GEV(n + 1));
  }
  if (n + 1 < nchunks) {
    load_ops(B, chunk0 + n + 1);
    step(A, chunk0 + n, GEV(n));
    step(B, chunk0 + n + 1, GEV(n + 1));
  } else {
    step(A, chunk0 + n, GEV(n));
  }
#undef GEV
#undef LBAR
  float* so;
  if (seq < 2) so = p.out + (type ? O_DNP : O_RETP) + (((size_t)l * 2 + seq) * 4 + h) * 16384;
  else so = p.out + (type ? O_DNS : O_RETS) + (((size_t)l * 32 + (seq - 2)) * 4 + h) * 16384;
#pragma unroll
  for (int e = 0; e < 16; e++) {
    int dk = w * 32 + (e & 3) + 8 * (e >> 2) + 4 * hh;
    so[(size_t)dk * 128 + dv0 + r] = S[e];
  }
  __syncthreads();
}

__device__ void scan_phase(const Params& p, int l) {
  const int G = gridDim.x, b = blockIdx.x;
  if (G >= 128) {
    if (b < 64) {
      int type = (b < 32) ? 1 : 0;
      int bh = b & 7, s = (b >> 3) & 3;
      scan_task(p, l, type, bh >> 2, bh & 3, s);
    } else {
      for (int u = b - 64; u < 1024; u += G - 64) {
        int type = u & 1, s = (u >> 1) & 3, h = (u >> 3) & 3, bb = u >> 5;
        scan_task(p, l, type, 2 + bb, h, s);
      }
    }
  } else {
    for (int t = b; t < 1088; t += G) {
      if (t < 64) {
        int type = (t < 32) ? 1 : 0;
        int bh = t & 7, s = (t >> 3) & 3;
        scan_task(p, l, type, bh >> 2, bh & 3, s);
      } else {
        int u = t - 64;
        int type = u & 1, s = (u >> 1) & 3, h = (u >> 3) & 3, bb = u >> 5;
        scan_task(p, l, type, 2 + bb, h, s);
      }
    }
  }
}

__device__ void fin_phase(const Params& p, int l) {
  const int tid = otid();
  const int lane = tid & 63, w = tid >> 6;
  u16* XN = (u16*)(p.ws + OFF_XN);
  const u16* Z = (const u16*)(p.ws + OFF_Z);
  for (int row = blockIdx.x * 4 + w; row < NTOK; row += gridDim.x * 4) {
    u16* op = XN + (size_t)row * DM + lane * 16;
    bf16x8 o0 = *(const bf16x8*)op, o1 = *(const bf16x8*)(op + 8);
    float v[16];
#pragma unroll
    for (int e = 0; e < 8; e++) { v[e] = bfs(o0[e]); v[8 + e] = bfs(o1[e]); }
    const bool ret = lane < 32;
    float s1 = 0.f, s2 = 0.f;
#pragma unroll
    for (int e = 0; e < 16; e++) { s1 += v[e]; s2 += v[e] * v[e]; }
    s1 += __shfl_xor(s1, 1); s1 += __shfl_xor(s1, 2); s1 += __shfl_xor(s1, 4);
    s2 += __shfl_xor(s2, 1); s2 += __shfl_xor(s2, 2); s2 += __shfl_xor(s2, 4);
    float mu = ret ? s1 * (1.f / 128.f) : 0.f;
    float var = s2 * (1.f / 128.f) - mu * mu;
    var = fmaxf(var, 0.f);
    float rstd = rsqrtf(var + EPS);
    const int col = lane * 16;
    const u16* gp = Z + (size_t)row * ZC + (ret ? 1536 + col : 3584 + (col - 512));
    bf16x8 g0 = *(const bf16x8*)gp, g1 = *(const bf16x8*)(gp + 8);
    const float* ng = ret ? p.ret_norm_g + (size_t)l * 512 + col : p.dn_norm_g + (size_t)l * 128 + (col & 127);
    bf16x8 r0, r1;
#pragma unroll
    for (int e = 0; e < 16; e++) {
      float gt = bfs(e < 8 ? g0[e & 7] : g1[e & 7]);
      float y = (v[e] - mu) * rstd * ng[e] * (gt * sigmoidf_(gt));
      if (e < 8) r0[e & 7] = (short)f2bf(y); else r1[e & 7] = (short)f2bf(y);
    }
    *(bf16x8*)op = r0;
    *(bf16x8*)(op + 8) = r1;
  }
}


#define XB_TMO      128
#define XB_XCNT(j)  (256  + 64 * (j))
#define XB_XSUB(j)  (1280 + 64 * (j))
#define XB_XGEN(j)  (2304 + 64 * (j))
#define XB_TOP      3328
#define XB_TOPGEN   3392
#define XCD_BAR_WORDS 3456
#define XB_SPIN_CAP (1u << 22)
#define LAS __attribute__((address_space(3)))
DEVI unsigned xb_ld(unsigned* p) { return __hip_atomic_load(p, __ATOMIC_RELAXED, __HIP_MEMORY_SCOPE_AGENT); }
DEVI unsigned xb_add(unsigned* p, unsigned v) { return __hip_atomic_fetch_add(p, v, __ATOMIC_RELAXED, __HIP_MEMORY_SCOPE_AGENT); }
DEVI unsigned xb_xcc_id() { return (unsigned)__builtin_amdgcn_s_getreg((3 << 11) | 20) & 0xFu; }
#define XB_SPIN(cond, bar) do { unsigned _sp = 0; while (cond) { __builtin_amdgcn_s_sleep(1); \
    if ((++_sp & 255u) == 0u) { if (xb_ld(&(bar)[XB_TMO])) break; if (_sp > XB_SPIN_CAP) { atomicAdd(&(bar)[XB_TMO], 1u); break; } } } } while (0)
struct XcdBarrier { unsigned* bar; unsigned x; volatile LAS unsigned* st; };
DEVI XcdBarrier xcd_barrier_post(unsigned* bar, volatile LAS unsigned* st) {
  XcdBarrier b; b.bar = bar; b.x = xb_xcc_id(); b.st = st;
  if (threadIdx.x == 0) (void)xb_add(&bar[XB_XCNT(b.x)], 1u);
  return b;
}
DEVI void xcd_barrier_complete(unsigned* bar, unsigned x, unsigned& nloc, unsigned& nx) {
  const unsigned G = gridDim.x * gridDim.y * gridDim.z;
  unsigned sum, cnt, mine, sp = 0u;
  for (;;) {
    sum = 0u; cnt = 0u; mine = 0u;
#pragma unroll
    for (unsigned j = 0; j < 16; ++j) { const unsigned c = xb_ld(&bar[XB_XCNT(j)]); sum += c; cnt += (c > 0u) ? 1u : 0u; mine = (j == x) ? c : mine; }
    if (sum == G) break;
    __builtin_amdgcn_s_sleep(1);
    if ((++sp & 255u) == 0u) { if (xb_ld(&bar[XB_TMO])) break; if (sp > XB_SPIN_CAP) { atomicAdd(&bar[XB_TMO], 1u); break; } }
  }
  nloc = mine > 0u ? mine : 1u; nx = cnt > 0u ? cnt : 1u;
}
DEVI void xcd_barrier(const XcdBarrier& b) {
  asm volatile("s_waitcnt vmcnt(0)" ::: "memory");
  __syncthreads();
  if (threadIdx.x == 0) {
    unsigned* bar = b.bar;
    __builtin_amdgcn_s_waitcnt(0);
    unsigned nloc = b.st[0], nx = b.st[1];
    if (nloc == 0u) { xcd_barrier_complete(bar, b.x, nloc, nx); b.st[0] = nloc; b.st[1] = nx; }
    const unsigned old = xb_add(&bar[XB_XSUB(b.x)], 1u);
    const unsigned gen = old / nloc;
    if (old + 1u == (gen + 1u) * nloc) {
      __builtin_amdgcn_fence(__ATOMIC_RELEASE, "agent");
      asm volatile("s_waitcnt vmcnt(0)" ::: "memory");
      const unsigned og = xb_add(&bar[XB_TOP], 1u);
      const unsigned tg = og / nx;
      if (og + 1u == (tg + 1u) * nx) xb_add(&bar[XB_TOPGEN], 1u);
      else XB_SPIN(xb_ld(&bar[XB_TOPGEN]) == tg, bar);
      __builtin_amdgcn_fence(__ATOMIC_ACQUIRE, "agent");
      xb_add(&bar[XB_XGEN(b.x)], 1u);
      asm volatile("s_waitcnt vmcnt(0)" ::: "memory");
    } else {
      XB_SPIN(xb_ld(&bar[XB_XGEN(b.x)]) == gen, bar);
      __builtin_amdgcn_fence(__ATOMIC_ACQUIRE, "agent");
      asm volatile("s_waitcnt vmcnt(0)" ::: "memory");
    }
  }
  __syncthreads();
}

__global__ void __launch_bounds__(NTHR, 2) fwd_kernel(Params p) {
  const u16* WT = (const u16*)p.ws;
  const u16* XN = (const u16*)(p.ws + OFF_XN);
  const u16* Zc = (const u16*)(p.ws + OFF_Z);
  XcdBarrier xb;
  if (p.coop == 1) {
    volatile LAS unsigned* st = (volatile LAS unsigned*)(smem + LDS_BYTES - 16);
    if (threadIdx.x == 0) { st[0] = 0u; st[1] = 0u; }
    __syncthreads();
    xb = xcd_barrier_post((unsigned*)(p.ws + OFF_BAR), st);
  }
  for (int ph = p.phase_lo; ph < p.phase_hi; ph++) {
    if (ph == 0) continue;
    if (ph == 23) {
      norm_phase<4>(p, 0, p.final_norm_g);
    } else {
      const int l = (ph - 1) / 11, sub = (ph - 1) % 11;
      switch (sub) {
        case 0:
          if (l == 0) { convert_weights(p, 0); norm_phase<0>(p, l, p.norm1_g); }
          else { convert_weights(p, l); norm_phase<1>(p, l, p.norm1_g + (size_t)l * 1024); }
          break;
        case 1: gemm_phase<0>(p, l, XN, 1024, WT + WT_IN, 1024, 4096, 1024); break;
        case 2:
          for (int t = blockIdx.x; t < 2304; t += gridDim.x) {
            int type, idx;
            if (t < 2048) { type = (t >> 9) & 1; idx = (t >> 10) * 512 + (t & 511); }
            else { type = t & 1; idx = 1024 + ((t - 2048) >> 1); }
            const int h = idx & 3, chunk = idx >> 2;
            if (type) c2_delta(p, l, chunk, h); else c2_ret(p, l, chunk, h);
          }
          break;
        case 3: scan_phase(p, l); break;
        case 4: fin_phase(p, l); break;
        case 5: gemm_phase<1>(p, l, XN, 1024, WT + WT_OUT, 1024, 1024, 1024); break;
        case 6: norm_phase<2>(p, l, p.norm2_g + (size_t)l * 1024); break;
        case 7: gemm_phase<2>(p, l, XN, 1024, WT + WT_UP, 1024, 4096, 1024); break;
        case 8: gemm_phase<1>(p, l, Zc, 4096, WT + WT_DOWN, 4096, 1024, 4096); break;
        case 9: norm_phase<3>(p, l, p.ple_norm_g + (size_t)l * 1024); break;
        case 10: gemm_phase<3>(p, l, XN, 1024, WT + WT_GATE, 1024, 1024, 1024); break;
      }
    }
    if (ph + 1 < p.phase_hi) {
      if (p.coop == 1) xcd_barrier(xb);
      else if (p.coop == 2) cg::this_grid().sync();
    }
  }
}

extern "C" void kernel_launch(void* const* d_in, const int* in_sizes, int n_in, void* d_out, int out_size, void* d_ws,
                              size_t ws_size, hipStream_t stream) {
  static int grid_blocks = 0;
  if (!grid_blocks) {
    int dev = 0, cus = 0, per_cu = 0;
    hipGetDevice(&dev);
    hipDeviceGetAttribute(&cus, hipDeviceAttributeMultiprocessorCount, dev);
    hipFuncSetAttribute((const void*)fwd_kernel, hipFuncAttributeMaxDynamicSharedMemorySize, LDS_BYTES);
    hipOccupancyMaxActiveBlocksPerMultiprocessor(&per_cu, fwd_kernel, NTHR, LDS_BYTES);
    if (per_cu < 1) per_cu = 1;
    if (per_cu > 2) per_cu = 2;
    grid_blocks = cus * per_cu;
  }
  Params p{};
  const float** f = (const float**)&p;
  for (int i = 0; i < 23; i++) f[i] = (const float*)d_in[i];
  p.out = (float*)d_out;
  p.ws = (char*)d_ws;
  p.pad = 0;
#ifndef ONE_LAUNCH
  p.coop = 0;
  for (int ph = 0; ph < 24; ph++) {
    p.phase_lo = ph;
    p.phase_hi = ph + 1;
    hipLaunchKernelGGL(fwd_kernel, dim3(grid_blocks), dim3(NTHR), LDS_BYTES, stream, p);
  }
#else
  p.coop = 1;
  hipMemsetAsync((char*)d_ws + OFF_BAR, 0, XCD_BAR_WORDS * 4, stream);
  p.phase_lo = 0;
  p.phase_hi = 24;
  void* args[] = {&p};
  hipError_t e = hipLaunchCooperativeKernel((void*)fwd_kernel, dim3(grid_blocks), dim3(NTHR), args, LDS_BYTES, stream);
  if (e != hipSuccess) fprintf(stderr, "cooperative launch failed: %s (grid %d)\n", hipGetErrorString(e), grid_blocks);
#endif
}
```
